# Optimizing an MI355X kernel written in HIP

```python
import math
import jax, jax.numpy as jnp
from jax import lax
import numpy as np

D_MODEL = 1024
BATCH = 8
SEQ = 4096
DEPTH = 1
DEC_BATCH = 16
DEC_SEQ = 2048
PAST_LEN = 128

DA_HEADS = 4
DA_HEAD_DIM = 64
DA_V_DIM = 2 * DA_HEAD_DIM
DA_QK = DA_HEADS * 2 * DA_HEAD_DIM
DA_WIDTH = DA_HEADS * DA_V_DIM
GLA_HEADS = 4
GLA_DK = 64
GLA_DV = 128
GLA_QK = GLA_HEADS * GLA_DK
GLA_WIDTH = GLA_HEADS * GLA_DV
GLA_GATE_RANK = 16
GLA_GATE_TAU = 16.0
GLA_CHUNK = 64
N_BRANCHES = 2
REL_BUCKETS = 32
REL_MAX_DIST = 128
Q_BLOCK = 128
PEER_HEADS = 8
PEER_N_KEYS = 128
PEER_N_EXPERTS = PEER_N_KEYS * PEER_N_KEYS
PEER_TOPK = 16
PEER_QUERY_DIM = 256
PEER_HALF = PEER_QUERY_DIM // 2
PEER_TOKEN_BLOCK = 128
PLE_DIM = 256
EPS = 1e-6

IN_SIZES = (DA_QK, DA_QK, DA_WIDTH, GLA_QK, GLA_QK, GLA_WIDTH, GLA_WIDTH, 2 * GLA_GATE_RANK, N_BRANCHES * D_MODEL)
IN_DIM = DA_QK * 2 + DA_WIDTH + GLA_QK * 2 + GLA_WIDTH * 2 + 2 * GLA_GATE_RANK + N_BRANCHES * D_MODEL

kernel_name = "hybrid_diffattn_gla_peer_encoder"


def rmsnorm(x, g):
    xf = x.astype(jnp.float32)
    y = xf * lax.rsqrt(jnp.mean(xf * xf, axis=-1, keepdims=True) + EPS)
    return (y * g.astype(jnp.float32)).astype(x.dtype)


def split_in_proj(proj):
    idx, acc = [], 0
    for s in IN_SIZES[:-1]:
        acc += s
        idx.append(acc)
    return jnp.split(proj, idx, axis=-1)


def t5_bucket(rel):
    nb = REL_BUCKETS // 2
    max_exact = nb // 2
    ret = (rel > 0).astype(jnp.int32) * nb
    n = jnp.abs(rel)
    nf = jnp.maximum(n, 1).astype(jnp.float32)
    large = max_exact + (jnp.log(nf / max_exact) / math.log(REL_MAX_DIST / max_exact) * (nb - max_exact)).astype(jnp.int32)
    large = jnp.minimum(large, nb - 1)
    return ret + jnp.where(n < max_exact, n, large)


def diff_attention(q, k, v, lam, rel_bias):
    B, S, H, _, d = q.shape
    nb = S // Q_BLOCK
    scale = d ** -0.5
    qb = q.reshape(B, nb, Q_BLOCK, H, 2, d).transpose(1, 0, 2, 3, 4, 5)
    starts = jnp.arange(nb, dtype=jnp.int32) * Q_BLOCK
    kpos = jnp.arange(S, dtype=jnp.int32)
    qoff = jnp.arange(Q_BLOCK, dtype=jnp.int32)

    def one_block(args):
        qblk, s0 = args
        rel = kpos[None, :] - (s0 + qoff)[:, None]
        bias = jnp.take(rel_bias, t5_bucket(rel), axis=0)
        bias = bias.transpose(2, 0, 1).astype(jnp.float32)
        logits = jnp.einsum('bqhcd,bkhcd->bhcqk', qblk, k).astype(jnp.float32) * scale + bias[None, :, None]
        a = jax.nn.softmax(logits, axis=-1)
        w = a[:, :, 0] - lam * a[:, :, 1]
        return jnp.einsum('bhqk,bkhv->bqhv', w, v.astype(jnp.float32))

    o = lax.map(one_block, (qb, starts))
    return o.transpose(1, 0, 2, 3, 4).reshape(B, S, H, v.shape[-1])


def gla_chunked(q, k, v, log_a, strict):
    B, S, H, dk = q.shape
    dv = v.shape[-1]
    C = GLA_CHUNK
    nc = S // C
    f32 = jnp.float32
    q = q.astype(f32).reshape(B, nc, C, H, dk)
    k = k.astype(f32).reshape(B, nc, C, H, dk)
    v = v.astype(f32).reshape(B, nc, C, H, dv)
    b = jnp.cumsum(log_a.astype(f32).reshape(B, nc, C, H, dk), axis=2)
    b_last = b[:, :, -1:]
    qe = q * jnp.exp(b)
    ke = k * jnp.exp(-b)
    kd = k * jnp.exp(b_last - b)
    mask = jnp.tril(jnp.ones((C, C), dtype=bool), k=-1 if strict else 0)
    att = jnp.einsum('bnthk,bnshk->bnhts', qe, ke)
    att = jnp.where(mask, att, 0.0)
    o = jnp.einsum('bnhts,bnshv->bnthv', att, v)
    kv = jnp.einsum('bnshk,bnshv->bnhkv', kd, v)
    decay = jnp.exp(b_last[:, :, 0])

    def step(state, inp):
        dec, kvc = inp
        return dec[..., None] * state + kvc, state

    _, states = lax.scan(step, jnp.zeros((B, H, dk, dv), f32),
                         (decay.transpose(1, 0, 2, 3), kv.transpose(1, 0, 2, 3, 4)))
    states = states.transpose(1, 0, 2, 3, 4)
    o = o + jnp.einsum('bnthk,bnhkv->bnthv', qe, states)
    return o.reshape(B, S, H, dv)


def peer_ffn(h, w_q, sub_keys, u_tab, v_tab):
    B, S, D = h.shape
    tokens = h.reshape(-1, PEER_TOKEN_BLOCK, D)

    def one_block(hb):
        q = jnp.einsum('td,de->te', hb, w_q).reshape(-1, PEER_HEADS, 2, PEER_HALF)
        s = jnp.einsum('thcd,hcnd->thcn', q, sub_keys).astype(jnp.float32)
        v1, i1 = lax.top_k(s[:, :, 0], PEER_TOPK)
        v2, i2 = lax.top_k(s[:, :, 1], PEER_TOPK)
        cand = (v1[..., :, None] + v2[..., None, :]).reshape(-1, PEER_HEADS, PEER_TOPK * PEER_TOPK)
        cidx = (i1[..., :, None] * PEER_N_KEYS + i2[..., None, :]).reshape(-1, PEER_HEADS, PEER_TOPK * PEER_TOPK)
        top, pos = lax.top_k(cand, PEER_TOPK)
        idx = jnp.take_along_axis(cidx, pos, axis=-1)
        g = jax.nn.softmax(top, axis=-1)
        u = jnp.take(u_tab, idx, axis=0)
        act = jax.nn.gelu(jnp.einsum('thkd,td->thk', u, hb).astype(jnp.float32))
        vv = jnp.take(v_tab, idx, axis=0)
        return jnp.einsum('thk,thkd->td', (g * act).astype(vv.dtype), vv)

    out = lax.map(one_block, tokens)
    return out.reshape(B, S, D).astype(h.dtype)


def encoder_layer(x, p_i, layer_idx, rel_bias, norm1_g, w_in, lambda_qk, da_norm_g,
                  gla_alpha_w, gla_alpha_b, gla_norm_g, w_up_a, w_up_b, w_out,
                  norm2_g, peer_w_q, peer_sub_keys, peer_u, peer_v, norm3_g, ple_w, ple_gate_w):
    B, S, D = x.shape
    h = rmsnorm(x, norm1_g)
    proj = jnp.einsum('bsd,de->bse', h, w_in)
    qa, ka, va, qg, kg, vg, rg, lr, gl = split_in_proj(proj)

    lam_init = 0.8 - 0.6 * math.exp(-0.3 * layer_idx)
    lq = lambda_qk.astype(jnp.float32)
    lam = jnp.exp(jnp.sum(lq[0] * lq[1])) - jnp.exp(jnp.sum(lq[2] * lq[3])) + lam_init
    oa = diff_attention(qa.reshape(B, S, DA_HEADS, 2, DA_HEAD_DIM),
                        ka.reshape(B, S, DA_HEADS, 2, DA_HEAD_DIM),
                        va.reshape(B, S, DA_HEADS, DA_V_DIM), lam, rel_bias)
    oa = rmsnorm(oa, da_norm_g) * (1.0 - lam_init)
    ya = jnp.einsum('bse,ed->bsd', oa.reshape(B, S, DA_WIDTH).astype(x.dtype), w_up_a)

    qg = qg.reshape(B, S, GLA_HEADS, GLA_DK) * (GLA_DK ** -0.5)
    kg = kg.reshape(B, S, GLA_HEADS, GLA_DK)
    vg = vg.reshape(B, S, GLA_HEADS, GLA_DV)
    z = jnp.einsum('bsjr,jrk->bsjk', lr.reshape(B, S, 2, GLA_GATE_RANK), gla_alpha_w) + gla_alpha_b
    log_a = (jax.nn.log_sigmoid(z.astype(jnp.float32)) / GLA_GATE_TAU).reshape(B, S, 2, GLA_HEADS, GLA_DK)
    o_fwd = gla_chunked(qg, kg, vg, log_a[:, :, 0], strict=False)
    flip = lambda t: jnp.flip(t, axis=1)
    o_bwd = flip(gla_chunked(flip(qg), flip(kg), flip(vg), flip(log_a[:, :, 1]), strict=True))
    og = rmsnorm(o_fwd + o_bwd, gla_norm_g).reshape(B, S, GLA_WIDTH)
    og = (og * jax.nn.silu(rg.astype(jnp.float32))).astype(x.dtype)
    yb = jnp.einsum('bse,ed->bsd', og, w_up_b)

    gates = jax.nn.sigmoid(gl.reshape(B, S, N_BRANCHES, D).astype(jnp.float32)).astype(x.dtype)
    merged = gates[:, :, 0] * ya + gates[:, :, 1] * yb
    x = x + jnp.einsum('bsd,de->bse', merged, w_out)

    x = x + peer_ffn(rmsnorm(x, norm2_g), peer_w_q, peer_sub_keys, peer_u, peer_v)

    h3 = rmsnorm(x, norm3_g)
    gate = jax.nn.sigmoid(jnp.einsum('bsd,de->bse', h3, ple_gate_w).astype(jnp.float32)).astype(x.dtype)
    x = x + jnp.einsum('bsp,pd->bsd', p_i, ple_w) * gate
    return x


def run_trunk(x, p, rel_bias, norm1_g, w_in, lambda_qk, da_norm_g, gla_alpha_w, gla_alpha_b,
              gla_norm_g, w_up_a, w_up_b, w_out, norm2_g, peer_w_q, peer_sub_keys, peer_u,
              peer_v, norm3_g, ple_w, ple_gate_w, final_norm_g):
    for i in range(DEPTH):
        x = encoder_layer(x, p[i], i, rel_bias, norm1_g[i], w_in[i], lambda_qk[i], da_norm_g[i],
                          gla_alpha_w[i], gla_alpha_b[i], gla_norm_g[i], w_up_a[i], w_up_b[i], w_out[i],
                          norm2_g[i], peer_w_q[i], peer_sub_keys[i], peer_u[i], peer_v[i],
                          norm3_g[i], ple_w[i], ple_gate_w[i])
    return rmsnorm(x, final_norm_g)


def setup_inputs(seed: int = 0) -> dict:
    key = jax.random.key(seed)
    ks = jax.random.split(key, 24)
    f32 = jnp.float32

    def nrm(k, shape, scale):
        return jax.random.normal(k, shape, f32) * scale

    def gain(k, shape):
        return 1.0 + 0.05 * jax.random.normal(k, shape, f32)

    return {
        "x_prompt": nrm(ks[0], (BATCH, SEQ, D_MODEL), 1.0),
        "x_sample": nrm(ks[1], (DEC_BATCH, DEC_SEQ, D_MODEL), 1.0),
        "p_prompt": nrm(ks[2], (DEPTH, BATCH, SEQ, PLE_DIM), 1.0),
        "p_sample": nrm(ks[3], (DEPTH, DEC_BATCH, DEC_SEQ, PLE_DIM), 1.0),
        "rel_bias": nrm(ks[4], (REL_BUCKETS, DA_HEADS), 0.5),
        "norm1_g": gain(ks[5], (DEPTH, D_MODEL)),
        "w_in": nrm(ks[6], (DEPTH, D_MODEL, IN_DIM), D_MODEL ** -0.5),
        "lambda_qk": nrm(ks[7], (DEPTH, 4, DA_HEAD_DIM), 0.1),
        "da_norm_g": gain(ks[8], (DEPTH, DA_V_DIM)),
        "gla_alpha_w": nrm(ks[9], (DEPTH, 2, GLA_GATE_RANK, GLA_QK), GLA_GATE_RANK ** -0.5),
        "gla_alpha_b": nrm(ks[10], (DEPTH, 2, GLA_QK), 0.1),
        "gla_norm_g": gain(ks[11], (DEPTH, GLA_DV)),
        "w_up_a": nrm(ks[12], (DEPTH, DA_WIDTH, D_MODEL), DA_WIDTH ** -0.5),
        "w_up_b": nrm(ks[13], (DEPTH, GLA_WIDTH, D_MODEL), GLA_WIDTH ** -0.5),
        "w_out": nrm(ks[14], (DEPTH, D_MODEL, D_MODEL), D_MODEL ** -0.5),
        "norm2_g": gain(ks[15], (DEPTH, D_MODEL)),
        "peer_w_q": nrm(ks[16], (DEPTH, D_MODEL, PEER_HEADS * PEER_QUERY_DIM), D_MODEL ** -0.5),
        "peer_sub_keys": nrm(ks[17], (DEPTH, PEER_HEADS, 2, PEER_N_KEYS, PEER_HALF), PEER_HALF ** -0.5),
        "peer_u": nrm(ks[18], (DEPTH, PEER_N_EXPERTS, D_MODEL), D_MODEL ** -0.5),
        "peer_v": nrm(ks[19], (DEPTH, PEER_N_EXPERTS, D_MODEL), (PEER_HEADS * PEER_TOPK) ** -0.5),
        "norm3_g": gain(ks[20], (DEPTH, D_MODEL)),
        "ple_w": nrm(ks[21], (DEPTH, PLE_DIM, D_MODEL), PLE_DIM ** -0.5),
        "ple_gate_w": nrm(ks[22], (DEPTH, D_MODEL, D_MODEL), D_MODEL ** -0.5),
        "final_norm_g": gain(ks[23], (D_MODEL,)),
    }


def reference(x_prompt, x_sample, p_prompt, p_sample, rel_bias, norm1_g, w_in, lambda_qk, da_norm_g,
              gla_alpha_w, gla_alpha_b, gla_norm_g, w_up_a, w_up_b, w_out, norm2_g, peer_w_q,
              peer_sub_keys, peer_u, peer_v, norm3_g, ple_w, ple_gate_w, final_norm_g):
    y_prompt = run_trunk(x_prompt, p_prompt, rel_bias, norm1_g, w_in, lambda_qk, da_norm_g, gla_alpha_w,
                         gla_alpha_b, gla_norm_g, w_up_a, w_up_b, w_out, norm2_g, peer_w_q, peer_sub_keys,
                         peer_u, peer_v, norm3_g, ple_w, ple_gate_w, final_norm_g)
    y_sample = run_trunk(x_sample, p_sample, rel_bias, norm1_g, w_in, lambda_qk, da_norm_g, gla_alpha_w,
                         gla_alpha_b, gla_norm_g, w_up_a, w_up_b, w_out, norm2_g, peer_w_q, peer_sub_keys,
                         peer_u, peer_v, norm3_g, ple_w, ple_gate_w, final_norm_g)
    return (y_prompt, y_sample)
```

```cpp
#include <hip/hip_runtime.h>
#include <hip/hip_cooperative_groups.h>
#include <stdint.h>
#include <stdio.h>
namespace cg = cooperative_groups;

#define LAS __attribute__((address_space(3)))
#define PLACE_PAD(n) asm volatile(".rept %0\n\ts_nop 0\n\t.endr" :: "n"(n))
typedef unsigned short bf16_t;
typedef short bf16x8 __attribute__((ext_vector_type(8)));
typedef short s16x4 __attribute__((ext_vector_type(4)));
typedef float f32x4 __attribute__((ext_vector_type(4)));
typedef float f32x16 __attribute__((ext_vector_type(16)));
typedef int i32x8 __attribute__((ext_vector_type(8)));
typedef unsigned u32x4 __attribute__((ext_vector_type(4)));
typedef unsigned u32x2 __attribute__((ext_vector_type(2)));

constexpr int DM = 1024, TG = 32768, NIN = 5632;
constexpr float EPS = 1e-6f;
constexpr float LOG2E = 1.4426950408889634f;
constexpr float QSCALE = 0.125f * LOG2E;
constexpr int NPH = 21;
constexpr int LDS_BYTES = 147456;
constexpr int LDSCTL_OFF = LDS_BYTES - 256;

constexpr size_t MB = (size_t)1 << 20;
constexpr size_t WS_CTL = 0;
constexpr size_t WS_SMALL = 65536;
constexpr size_t WS_ROW = 131072;
constexpr float RSQ_FIX = 4096.f, RSQ_INV = 1.f / 4096.f;
constexpr size_t WS_WIN = 1 * MB;
constexpr size_t WS_WUP = WS_WIN + 11 * MB;
constexpr size_t WS_WOUT = WS_WUP + 2 * MB;
constexpr size_t WS_WQ = WS_WOUT + 2 * MB;
constexpr size_t WS_WGATE = WS_WQ + 4 * MB;
constexpr size_t WS_WPLE = WS_WGATE + 2 * MB;
constexpr size_t WS_SK = WS_WPLE + 1 * MB;
constexpr size_t WS_UB = WS_SK + 1 * MB;
constexpr size_t WS_VB = WS_UB + 8 * MB;
constexpr size_t WS_ACT = WS_VB + 8 * MB;
constexpr size_t A_XB = WS_ACT;
constexpr size_t A_OA = A_XB;
constexpr size_t A_OG = A_XB + 32 * MB;
constexpr size_t A_PE = A_XB;
constexpr size_t A_QA = A_XB + 64 * MB;
constexpr size_t A_KA = A_QA + 32 * MB;
constexpr size_t A_VA = A_KA + 32 * MB;
constexpr size_t A_QG = A_VA + 32 * MB;
constexpr size_t A_KG = A_QG + 16 * MB;
constexpr size_t A_VG = A_KG + 16 * MB;
constexpr size_t A_LA = A_VG + 32 * MB;
constexpr size_t A_RGS = A_LA + 32 * MB;
constexpr size_t A_OF = A_RGS + 32 * MB;
constexpr size_t A_OB = A_OF + 32 * MB;
constexpr size_t A_PB = A_OB + 32 * MB;
constexpr size_t A_XBK = A_PB + 16 * MB;
constexpr size_t WS_END = A_XBK + 64 * MB;
constexpr size_t A_MERGED = A_QA;
constexpr size_t A_X2B = A_QA;
constexpr size_t A_X1B = A_VA;
constexpr size_t A_X3B = A_VA;
constexpr size_t A_Q = A_VG;
constexpr size_t A_IDX = A_OB;
constexpr size_t A_GW = A_OB + 8 * MB;
static_assert(A_RGS + 32 * MB == A_OF && A_Q + 128 * MB == A_OB, "layout");

struct Params {
    const float* in[24];
    float* out;
    unsigned char* ws;
    int ph_lo, ph_hi;
};

typedef __bf16 bf16x2_t __attribute__((ext_vector_type(2)));
typedef float f32x2 __attribute__((ext_vector_type(2)));
__device__ __forceinline__ unsigned cvt_pk_bf16(float lo, float hi) { const f32x2 v = {lo, hi}; const bf16x2_t b = __builtin_convertvector(v, bf16x2_t); return __builtin_bit_cast(unsigned, b); }
__device__ __forceinline__ bf16_t f2bf(float f) { return (bf16_t)(cvt_pk_bf16(f, 0.f) & 0xffffu); }
__device__ __forceinline__ float bf_lo(unsigned w) { return __uint_as_float(w << 16); }
__device__ __forceinline__ float bf_hi(unsigned w) { return __uint_as_float(w & 0xffff0000u); }
__device__ __forceinline__ float bf2f(bf16_t b) { return __uint_as_float((unsigned)b << 16); }
__device__ __forceinline__ int TIDX() { int t = threadIdx.x; asm volatile("" : "+v"(t)); return t; }
__device__ __forceinline__ int BIDX() { int b = blockIdx.x; asm volatile("" : "+v"(b)); return __builtin_amdgcn_readfirstlane(b); }
__device__ __forceinline__ float wave_sum(float v) {
#pragma unroll
    for (int o = 1; o < 64; o <<= 1) v += __shfl_xor(v, o);
    return v;
}
__device__ __forceinline__ float fast_sigmoid(float x) { return __builtin_amdgcn_rcpf(1.f + __expf(-x)); }
__device__ __forceinline__ float fast_exp2(float x) { return __builtin_amdgcn_exp2f(x); }
__device__ __forceinline__ int crow(int r, int hi) { return (r & 3) + 8 * (r >> 2) + 4 * hi; }
#define MFMA32(a, b, c) __builtin_amdgcn_mfma_f32_32x32x16_bf16(a, b, c, 0, 0, 0)
#define MFMA_F8(a, b, c) __builtin_amdgcn_mfma_scale_f32_32x32x64_f8f6f4(a, b, c, 0, 0, 0, 0x7F7F7F7F, 0, 0x7B7B7B7B)
#define MFMA16(a, b, c) __builtin_amdgcn_mfma_f32_16x16x32_bf16(a, b, c, 0, 0, 0)
typedef short v4i16_t __attribute__((ext_vector_type(4)));
__device__ __forceinline__ s16x4 lds_tr(LAS const unsigned char* p) { return __builtin_bit_cast(s16x4, __builtin_amdgcn_ds_read_tr16_b64_v4i16((LAS v4i16_t*)p)); }

namespace pg8 {
constexpr int BM = 256, BK = 64, HALF = 128, HTB = HALF * BK * 2, STAGE_BYTES = 8 * HTB, NXCD = 8, WGM = 8;
__host__ __device__ __forceinline__ int lds_byte(int r, int c) { const int st = (r >> 4) * 2 + (c >> 5), rr = r & 15, cc = c & 31, ob = rr * 64 + cc * 2; return st * 1024 + (ob ^ (((ob >> 9) & 1) << 5)); }
__host__ __device__ __forceinline__ void stage_rc(int b, int& R, int& C) { const int st = b / 1024, sb = b % 1024, swz = sb ^ (((sb >> 9) & 1) << 5); R = (st >> 1) * 16 + swz / 64; C = (st & 1) * 32 + (swz % 64) / 2; }
__host__ __device__ __forceinline__ int perm32(int rho) { const int n = rho >> 4, i = rho & 15; return 8 * (i >> 2) + 4 * n + (i & 3); }
struct Unit { int pm, pn; };
struct Gemm { const bf16_t* A; const bf16_t* Bt; int K; };
__device__ __forceinline__ void tile_of(int L, int nM, int nN, int& pm, int& pn) {
    const int nwg = nM * nN; int wgid = L;
    { const int q = nwg / NXCD, r = nwg % NXCD, xcd = wgid % NXCD, off = wgid / NXCD; wgid = (xcd < r ? xcd * (q + 1) : r * (q + 1) + (xcd - r) * q) + off; }
    const int nig = WGM * nN, gid = wgid / nig, fm = gid * WGM, gsz = (nM - fm) < WGM ? (nM - fm) : WGM;
    pm = fm + ((wgid % nig) % gsz); pn = (wgid % nig) / gsz;
}
struct StaticOrder {
    int nM, nN, G, c;
    __device__ void init(int M, int N, int G_, int c_) { nM = M / BM; nN = N / BM; G = G_; c = c_; }
    __device__ bool next(int i, Unit& u) const { const long L = (long)i * G + c; if (L >= (long)nM * nN) return false; tile_of((int)L, nM, nN, u.pm, u.pn); return true; }
};
struct PairOrder {
    int nM, nN, G, c;
    __device__ void init(int M, int N, int G_, int c_) { nM = M / BM; nN = N / BM; G = G_; c = c_; }
    __device__ bool next(int i, Unit& u) const { const long L = (long)(i >> 1) * G + c; if (L >= (long)nM * nN) return false; tile_of((int)L, nM, nN, u.pm, u.pn);
        if (i & 1) { u.pm += nM; u.pn += nN; } return true; }
};

template <int PAD = 0, class Epi, class Sched>
__device__ __forceinline__ void gemm_phase(LAS unsigned char* lds, const Gemm g, const Sched& S, const Epi& E) {
    const int tid = TIDX(), wid = __builtin_amdgcn_readfirstlane(tid >> 6), lane = tid & 63, wr = wid >> 2, wc = wid & 3, fr = lane & 15, fq = lane >> 4;
    const int K = g.K, nt = K / BK;
    unsigned voffA[2], voffB[2];
#pragma unroll
    for (int i = 0; i < 2; ++i) { int R, C; stage_rc(tid * 16 + i * 8192, R, C); const int Rb = Epi::PERM ? ((R & ~31) + perm32(R & 31)) : R;
        voffA[i] = (unsigned)(R * K + C) * 2u; voffB[i] = (unsigned)(Rb * K + C) * 2u; }
    const size_t kstep = (size_t)(BK * 2);
    const size_t hstep = (size_t)HALF * K * 2;
    const size_t tstep = 2 * hstep;
    const unsigned ldsw = (unsigned)wid * 1024u;
    const int aoff = lds_byte(wr * 64 + fr, fq * 8), boff = lds_byte(wc * 32 + fr, fq * 8);
#define PG8_SA(b, h) (((b) * 2 + (h)) * HTB)
#define PG8_SB(b, h) ((4 + (b) * 2 + (h)) * HTB)
#define PG8_STAGE(bufoff, gbase, voff) do { _Pragma("unroll") for (int _i = 0; _i < 2; ++_i) \
        __builtin_amdgcn_global_load_lds((const unsigned*)((const char*)(gbase) + (voff)[_i]), (LAS unsigned*)(lds + (bufoff) + ldsw + _i * 8192), 16, 0, 0); } while (0)
#define PG8_LDA(dst, b, h) do { _Pragma("unroll") for (int m = 0; m < 4; ++m) _Pragma("unroll") for (int k = 0; k < 2; ++k) dst[m][k] = *(const LAS bf16x8*)(lds + PG8_SA(b, h) + aoff + m * 2048 + k * 1024); } while (0)
#define PG8_LDB(dst, b, h) do { _Pragma("unroll") for (int n = 0; n < 2; ++n) _Pragma("unroll") for (int k = 0; k < 2; ++k) dst[n][k] = *(const LAS bf16x8*)(lds + PG8_SB(b, h) + boff + n * 2048 + k * 1024); } while (0)
#define PG8_MMA(ai, bj, At, Bt) do { __builtin_amdgcn_s_setprio(1); _Pragma("unroll") for (int m = 0; m < 4; ++m) _Pragma("unroll") for (int n = 0; n < 2; ++n) _Pragma("unroll") for (int k = 0; k < 2; ++k) \
        acc[ai][bj][m][n] = __builtin_amdgcn_mfma_f32_16x16x32_bf16(Bt[n][k], At[m][k], acc[ai][bj][m][n], 0, 0, 0); __builtin_amdgcn_s_setprio(0); } while (0)
#define PG8_WAIT_V(n) asm volatile("s_waitcnt vmcnt(" #n ")" ::: "memory")
#define PG8_WAIT_L(n) asm volatile("s_waitcnt lgkmcnt(" #n ")" ::: "memory")
#define PG8_BAR __builtin_amdgcn_s_barrier()
#define PG8_SCHED __builtin_amdgcn_sched_barrier(0)
    PLACE_PAD(PAD);
    Unit cur, nxt; int ui = 0;
    if (!S.next(0, cur)) return;
    f32x4 acc[2][2][4][2];
#pragma unroll
    for (int a = 0; a < 2; ++a)
#pragma unroll
        for (int b = 0; b < 2; ++b)
#pragma unroll
            for (int m = 0; m < 4; ++m)
#pragma unroll
                for (int n = 0; n < 2; ++n) acc[a][b][m][n] = (f32x4){0.f, 0.f, 0.f, 0.f};
    bf16x8 At[4][2], B0[2][2], B1[2][2];
    const char* cA = (const char*)g.A + (size_t)cur.pm * tstep; const char* cB = (const char*)g.Bt + (size_t)cur.pn * tstep;
    PG8_STAGE(PG8_SB(0, 0), cB, voffB); PG8_STAGE(PG8_SA(0, 0), cA, voffA); PG8_STAGE(PG8_SB(0, 1), cB + hstep, voffB); PG8_STAGE(PG8_SA(0, 1), cA + hstep, voffA);
    if (wr == 1) PG8_BAR;
    PG8_WAIT_V(4); PG8_BAR;
    PG8_STAGE(PG8_SB(1, 0), cB + kstep, voffB); PG8_STAGE(PG8_SA(1, 0), cA + kstep, voffA); PG8_STAGE(PG8_SB(1, 1), cB + hstep + kstep, voffB);
    PG8_WAIT_V(6); PG8_BAR;
    for (;;) {
        const bool has_next = S.next(ui + 1, nxt);
        const char* nA = has_next ? (const char*)g.A + (size_t)nxt.pm * tstep : cA; const char* nB = has_next ? (const char*)g.Bt + (size_t)nxt.pn * tstep : cB;
        for (int t = 0; t < nt; t += 2) {
            const bool last = (t == nt - 2);
            const char* a1 = cA + (size_t)(t + 1) * kstep;
            const char* a2 = last ? nA : cA + (size_t)(t + 2) * kstep; const char* b2 = last ? nB : cB + (size_t)(t + 2) * kstep;
            const char* a3 = a2 + kstep; const char* b3 = b2 + kstep;
            PG8_LDB(B0, 0, 0); PG8_SCHED; PG8_LDA(At, 0, 0); PG8_STAGE(PG8_SA(1, 1), a1 + hstep, voffA);
            PG8_WAIT_L(8); PG8_BAR; PG8_WAIT_L(0); PG8_MMA(0, 0, At, B0); PG8_BAR; PG8_SCHED;
            PG8_LDB(B1, 0, 1); PG8_STAGE(PG8_SB(0, 0), b2, voffB);
            PG8_BAR; PG8_WAIT_L(0); PG8_MMA(0, 1, At, B1); PG8_BAR;
            PG8_LDA(At, 0, 1); PG8_STAGE(PG8_SA(0, 0), a2, voffA);
            PG8_BAR; PG8_WAIT_L(0); PG8_MMA(1, 0, At, B0); PG8_BAR; PG8_SCHED;
            PG8_STAGE(PG8_SB(0, 1), b2 + hstep, voffB);
            PG8_WAIT_V(6); PG8_BAR; PG8_MMA(1, 1, At, B1); PG8_BAR;
            PG8_LDB(B0, 1, 0); PG8_SCHED; PG8_LDA(At, 1, 0); PG8_STAGE(PG8_SA(0, 1), a2 + hstep, voffA);
            PG8_WAIT_L(8); PG8_BAR; PG8_WAIT_L(0); PG8_MMA(0, 0, At, B0); PG8_BAR; PG8_SCHED;
            PG8_LDB(B1, 1, 1); PG8_STAGE(PG8_SB(1, 0), b3, voffB);
            PG8_BAR; PG8_WAIT_L(0); PG8_MMA(0, 1, At, B1); PG8_BAR;
            PG8_LDA(At, 1, 1); PG8_STAGE(PG8_SA(1, 0), a3, voffA);
            PG8_BAR; PG8_WAIT_L(0); PG8_MMA(1, 0, At, B0); PG8_BAR; PG8_SCHED;
            PG8_STAGE(PG8_SB(1, 1), b3 + hstep, voffB);
            PG8_WAIT_V(6); PG8_BAR; PG8_MMA(1, 1, At, B1); PG8_BAR;
        }
        E(acc, cur, wr, wc, fr, fq);
        if (!has_next) break;
#pragma unroll
        for (int a = 0; a < 2; ++a)
#pragma unroll
            for (int b = 0; b < 2; ++b)
#pragma unroll
                for (int m = 0; m < 4; ++m)
#pragma unroll
                    for (int n = 0; n < 2; ++n) acc[a][b][m][n] = (f32x4){0.f, 0.f, 0.f, 0.f};
        cur = nxt; cA = nA; cB = nB; ++ui;
    }
    PG8_WAIT_V(0);
    if (wr == 0) PG8_BAR;
    PG8_BAR;
    PLACE_PAD((16 - PAD) % 16);
#undef PG8_SA
#undef PG8_SB
#undef PG8_STAGE
#undef PG8_LDA
#undef PG8_LDB
#undef PG8_MMA
#undef PG8_WAIT_V
#undef PG8_WAIT_L
#undef PG8_BAR
#undef PG8_SCHED
}
}
using pg8::Unit;


enum { IN_XP = 0, IN_XS, IN_PP, IN_PS, IN_RELB, IN_N1G, IN_WIN, IN_LQK, IN_DAG, IN_AW, IN_AB, IN_GLAG, IN_WUPA, IN_WUPB, IN_WOUT, IN_N2G, IN_WQ, IN_SK, IN_PU, IN_PV, IN_N3G, IN_PLEW, IN_PLEG, IN_FG };
constexpr int SM_LAM = 2048;
constexpr float U_SCALE = 96.f, V_SCALE = 24.f;

struct EpiInProj {
    static constexpr bool PERM = true;
    const float* rs; const float* zb; unsigned char* ws; bf16_t* gl;
    __device__ __forceinline__ void operator()(const f32x4 (&acc)[2][2][4][2], const Unit& u, int wr, int wc, int fr, int fq) const {
        const int pn = u.pn;
        bf16_t* base; int ld, colt, mode = 0; float sc = 1.f;
        if (pn < 2)       { base = (bf16_t*)(ws + A_QA); ld = 512; colt = pn * 256; sc = QSCALE * 16.f; mode = 4; }
        else if (pn < 4)  { base = (bf16_t*)(ws + A_KA); ld = 512; colt = (pn - 2) * 256; mode = 4; }
        else if (pn < 6)  { base = (bf16_t*)(ws + A_VA); ld = 512; colt = (pn - 4) * 256; }
        else if (pn == 6) { base = (bf16_t*)(ws + A_QG); ld = 256; colt = 0; sc = 0.125f; }
        else if (pn == 7) { base = (bf16_t*)(ws + A_KG); ld = 256; colt = 0; }
        else if (pn < 10) { base = (bf16_t*)(ws + A_VG); ld = 512; colt = (pn - 8) * 256; }
        else if (pn < 12) { base = (bf16_t*)(ws + A_RGS); ld = 512; colt = (pn - 10) * 256; mode = 1; }
        else if (pn < 14) { base = (bf16_t*)(ws + A_LA); ld = 512; colt = (pn - 12) * 256; mode = 2; }
        else              { base = gl; ld = 2048; colt = (pn - 14) * 256; mode = 3; }
        const bool blk = (pn == 6) | (pn == 7) | (pn == 12) | (pn == 13);
        const int row0 = u.pm * 256 + wr * 64 + fr, col0 = colt + wc * 32 + 8 * fq;
        float zbv[2][8];
#pragma unroll
        for (int bj = 0; bj < 2; ++bj)
#pragma unroll
            for (int j = 0; j < 8; ++j) zbv[bj][j] = (mode == 2) ? zb[col0 + bj * 128 + j] : 0.f;
        float rsv[2][4];
#pragma unroll
        for (int ai = 0; ai < 2; ++ai)
#pragma unroll
            for (int m = 0; m < 4; ++m) rsv[ai][m] = rs[row0 + ai * 128 + m * 16];
        if (mode >= 3) {
            unsigned char* bbase = (mode == 3) ? (unsigned char*)gl : (unsigned char*)base; const int ldb = (mode == 3) ? 2048 : 512; const int odd = fq & 1;
#pragma unroll
            for (int ai = 0; ai < 2; ++ai)
#pragma unroll
                for (int mp = 0; mp < 4; mp += 2)
#pragma unroll
                    for (int bj = 0; bj < 2; ++bj) {
                        unsigned wv[2][2];
#pragma unroll
                        for (int k = 0; k < 2; ++k) { const int m = mp + k; const float r = rsv[ai][m] * sc; float v[8];
#pragma unroll
                            for (int j = 0; j < 4; ++j) { v[j] = acc[ai][bj][m][0][j] * r; v[4 + j] = acc[ai][bj][m][1][j] * r; }
                            unsigned w0 = 0u, w1 = 0u;
                            if (mode == 4) {
#pragma unroll
                                for (int j = 0; j < 8; ++j) v[j] = __builtin_amdgcn_fmed3f(v[j], -448.f, 448.f);
                                w0 = __builtin_amdgcn_cvt_pk_fp8_f32(v[0], v[1], w0, false); w0 = __builtin_amdgcn_cvt_pk_fp8_f32(v[2], v[3], w0, true);
                                w1 = __builtin_amdgcn_cvt_pk_fp8_f32(v[4], v[5], w1, false); w1 = __builtin_amdgcn_cvt_pk_fp8_f32(v[6], v[7], w1, true);
                            } else {
#pragma unroll
                                for (int j = 0; j < 4; ++j) { w0 = __builtin_amdgcn_cvt_pk_u8_f32(255.f * fast_sigmoid(v[j]), j, w0); w1 = __builtin_amdgcn_cvt_pk_u8_f32(255.f * fast_sigmoid(v[4 + j]), j, w1); }
                            }
                            wv[k][0] = w0; wv[k][1] = w1; }
                        const auto s0 = __builtin_amdgcn_permlane16_swap(wv[0][0], wv[1][0], false, false), s1 = __builtin_amdgcn_permlane16_swap(wv[0][1], wv[1][1], false, false);
                        const int row = row0 + ai * 128 + (mp + odd) * 16;
                        *(u32x4*)(bbase + (size_t)row * ldb + col0 - 8 * odd + bj * 128) = (u32x4){s0[0], s1[0], s0[1], s1[1]};
                    }
            return;
        }
#pragma unroll
        for (int ai = 0; ai < 2; ++ai)
#pragma unroll
            for (int m = 0; m < 4; ++m) {
                const int row = row0 + ai * 128 + m * 16; const float r = rsv[ai][m] * sc;
                bf16_t* rowp = blk ? base + (size_t)(row >> 6) * (64 * ld) + (row & 63) * 8 + (col0 >> 3) * 512 : base + (size_t)row * ld + col0;
#pragma unroll
                for (int bj = 0; bj < 2; ++bj) {
                    float v[8];
#pragma unroll
                    for (int j = 0; j < 4; ++j) { v[j] = acc[ai][bj][m][0][j] * r; v[4 + j] = acc[ai][bj][m][1][j] * r; }
                    if (mode == 1) {
#pragma unroll
                        for (int j = 0; j < 8; ++j) v[j] = v[j] * fast_sigmoid(v[j]);
                    } else if (mode == 2) {
#pragma unroll
                        for (int j = 0; j < 8; ++j) { const float z = v[j] + zbv[bj][j]; v[j] = (fminf(z, 0.f) - __logf(1.f + __expf(-fabsf(z)))) * 0.0625f; }
                    }
                    u32x4 w; w.x = cvt_pk_bf16(v[0], v[1]); w.y = cvt_pk_bf16(v[2], v[3]); w.z = cvt_pk_bf16(v[4], v[5]); w.w = cvt_pk_bf16(v[6], v[7]);
                    *(u32x4*)(rowp + bj * (blk ? 8192 : 128)) = w;
                }
            }
    }
};
struct EpiUp {
    static constexpr bool PERM = true;
    const unsigned char* gl; bf16_t* merged;
    static __device__ __forceinline__ float gb(unsigned w, int j) { return (float)((w >> (8 * j)) & 0xffu) * (1.f / 255.f); }
    __device__ __forceinline__ void operator()(const f32x4 (&acc)[2][2][4][2], const Unit& u, int wr, int wc, int fr, int fq) const {
        const int pass = u.pm >= (TG / 256) ? 1 : 0; const int pm = u.pm - pass * (TG / 256), pn = u.pn - pass * 4;
        const int row0 = pm * 256 + wr * 64 + fr, col0 = pn * 256 + wc * 32 + 8 * fq;
        if (!pass) {
#pragma unroll
            for (int ai = 0; ai < 2; ++ai) { u32x2 gt[4][2];
#pragma unroll
                for (int m = 0; m < 4; ++m)
#pragma unroll
                    for (int bj = 0; bj < 2; ++bj) gt[m][bj] = *(const u32x2*)(gl + (size_t)(row0 + ai * 128 + m * 16) * 2048 + col0 + bj * 128);
#pragma unroll
                for (int m = 0; m < 4; ++m)
#pragma unroll
                    for (int bj = 0; bj < 2; ++bj) { const size_t row = row0 + ai * 128 + m * 16; const int c = col0 + bj * 128; const u32x2 g = gt[m][bj]; float v[8];
#pragma unroll
                        for (int j = 0; j < 4; ++j) { v[j] = acc[ai][bj][m][0][j] * gb(g.x, j); v[4 + j] = acc[ai][bj][m][1][j] * gb(g.y, j); }
                        *(u32x4*)(merged + row * 1024 + c) = (u32x4){cvt_pk_bf16(v[0], v[1]), cvt_pk_bf16(v[2], v[3]), cvt_pk_bf16(v[4], v[5]), cvt_pk_bf16(v[6], v[7])}; } }
        } else {
#pragma unroll
            for (int am = 0; am < 4; ++am) { const int ai = am >> 1, mb = (am & 1) * 2;
                u32x2 gt[4][2]; u32x4 ov[4][2];
#pragma unroll
                for (int m = mb; m < mb + 2; ++m)
#pragma unroll
                    for (int bj = 0; bj < 2; ++bj) { const size_t row = row0 + ai * 128 + m * 16; const int c = col0 + bj * 128;
                        gt[m][bj] = *(const u32x2*)(gl + row * 2048 + 1024 + c); ov[m][bj] = *(const u32x4*)(merged + row * 1024 + c); }
#pragma unroll
                for (int m = mb; m < mb + 2; ++m)
#pragma unroll
                    for (int bj = 0; bj < 2; ++bj) { const size_t row = row0 + ai * 128 + m * 16; const int c = col0 + bj * 128;
                        const u32x2 g = gt[m][bj]; const u32x4 o = ov[m][bj]; float v[8];
                        const float of[8] = {bf_lo(o.x), bf_hi(o.x), bf_lo(o.y), bf_hi(o.y), bf_lo(o.z), bf_hi(o.z), bf_lo(o.w), bf_hi(o.w)};
#pragma unroll
                        for (int j = 0; j < 4; ++j) { v[j] = acc[ai][bj][m][0][j] * gb(g.x, j) + of[j]; v[4 + j] = acc[ai][bj][m][1][j] * gb(g.y, j) + of[4 + j]; }
                        *(u32x4*)(merged + row * 1024 + c) = (u32x4){cvt_pk_bf16(v[0], v[1]), cvt_pk_bf16(v[2], v[3]), cvt_pk_bf16(v[4], v[5]), cvt_pk_bf16(v[6], v[7])}; }
            }
        }
    }
};
struct EpiOut {
    static constexpr bool PERM = true;
    const bf16_t* xb; bf16_t* x1b; unsigned* rowsq;
    __device__ __forceinline__ void operator()(const f32x4 (&acc)[2][2][4][2], const Unit& u, int wr, int wc, int fr, int fq) const {
        const int row0 = u.pm * 256 + wr * 64 + fr, col0 = u.pn * 256 + wc * 32 + 8 * fq;
#pragma unroll
        for (int ai = 0; ai < 2; ++ai) {
            u32x4 xw[4][2];
#pragma unroll
            for (int m = 0; m < 4; ++m)
#pragma unroll
                for (int bj = 0; bj < 2; ++bj) xw[m][bj] = *(const u32x4*)(xb + (size_t)(row0 + ai * 128 + m * 16) * 1024 + col0 + bj * 128);
#pragma unroll
            for (int m = 0; m < 4; ++m) {
                const int row = row0 + ai * 128 + m * 16; float ss = 0.f;
#pragma unroll
                for (int bj = 0; bj < 2; ++bj) {
                    const size_t off = (size_t)row * 1024 + col0 + bj * 128; const u32x4 w = xw[m][bj];
                    const f32x4 o0 = (f32x4){bf_lo(w.x), bf_hi(w.x), bf_lo(w.y), bf_hi(w.y)} + acc[ai][bj][m][0], o1 = (f32x4){bf_lo(w.z), bf_hi(w.z), bf_lo(w.w), bf_hi(w.w)} + acc[ai][bj][m][1];
                    *(u32x4*)(x1b + off) = (u32x4){cvt_pk_bf16(o0[0], o0[1]), cvt_pk_bf16(o0[2], o0[3]), cvt_pk_bf16(o1[0], o1[1]), cvt_pk_bf16(o1[2], o1[3])};
                    ss += ((o0[0] * o0[0] + o0[1] * o0[1]) + (o0[2] * o0[2] + o0[3] * o0[3])) + ((o1[0] * o1[0] + o1[1] * o1[1]) + (o1[2] * o1[2] + o1[3] * o1[3]));
                }
                ss += __shfl_xor(ss, 16); ss += __shfl_xor(ss, 32);
                if (fq == 0) atomicAdd(rowsq + row, (unsigned)(ss * RSQ_FIX + 0.5f));
            }
        }
    }
};
struct EpiQ {
    static constexpr bool PERM = true;
    const unsigned* rowsq; bf16_t* q;
    __device__ __forceinline__ void operator()(const f32x4 (&acc)[2][2][4][2], const Unit& u, int wr, int wc, int fr, int fq) const {
        const int row0 = u.pm * 256 + wr * 64 + fr, col0 = u.pn * 256 + wc * 32 + 8 * fq;
        float rsv[2][4];
#pragma unroll
        for (int ai = 0; ai < 2; ++ai)
#pragma unroll
            for (int m = 0; m < 4; ++m) rsv[ai][m] = (float)rowsq[row0 + ai * 128 + m * 16] * RSQ_INV;
#pragma unroll
        for (int ai = 0; ai < 2; ++ai)
#pragma unroll
            for (int m = 0; m < 4; ++m) {
                const int row = row0 + ai * 128 + m * 16; const float r = rsqrtf(rsv[ai][m] * (1.f / 1024.f) + EPS);
#pragma unroll
                for (int bj = 0; bj < 2; ++bj) {
                    const f32x4 a = acc[ai][bj][m][0] * r, b = acc[ai][bj][m][1] * r;
                    u32x4 w; w.x = cvt_pk_bf16(a[0], a[1]); w.y = cvt_pk_bf16(a[2], a[3]); w.z = cvt_pk_bf16(b[0], b[1]); w.w = cvt_pk_bf16(b[2], b[3]);
                    *(u32x4*)(q + (size_t)row * 2048 + col0 + bj * 128) = w;
                }
            }
    }
};
struct EpiPe {
    static constexpr bool PERM = true;
    bf16_t* pe;
    __device__ __forceinline__ void operator()(const f32x4 (&acc)[2][2][4][2], const Unit& u, int wr, int wc, int fr, int fq) const {
        const int row0 = u.pm * 256 + wr * 64 + fr, col0 = u.pn * 256 + wc * 32 + 8 * fq;
#pragma unroll
        for (int ai = 0; ai < 2; ++ai)
#pragma unroll
            for (int m = 0; m < 4; ++m) {
                const int row = row0 + ai * 128 + m * 16;
#pragma unroll
                for (int bj = 0; bj < 2; ++bj) {
                    const f32x4 a = acc[ai][bj][m][0], b = acc[ai][bj][m][1];
                    u32x4 w; w.x = cvt_pk_bf16(a[0], a[1]); w.y = cvt_pk_bf16(a[2], a[3]); w.z = cvt_pk_bf16(b[0], b[1]); w.w = cvt_pk_bf16(b[2], b[3]);
                    *(u32x4*)(pe + (size_t)row * 1024 + col0 + bj * 128) = w;
                }
            }
    }
};
struct EpiGate {
    static constexpr bool PERM = true;
    const float* rs3; const bf16_t* pe; const bf16_t* x2b; bf16_t* x3b; unsigned* rowsq;
    __device__ __forceinline__ void operator()(const f32x4 (&acc)[2][2][4][2], const Unit& u, int wr, int wc, int fr, int fq) const {
        const int row0 = u.pm * 256 + wr * 64 + fr, col0 = u.pn * 256 + wc * 32 + 8 * fq;
#pragma unroll
        for (int am = 0; am < 4; ++am) { const int ai = am >> 1, mb = (am & 1) * 2;
            u32x4 pwv[4][2], xwv[4][2]; float rv[4];
#pragma unroll
            for (int m = mb; m < mb + 2; ++m) { rv[m] = rs3[row0 + ai * 128 + m * 16];
#pragma unroll
                for (int bj = 0; bj < 2; ++bj) { const size_t off = (size_t)(row0 + ai * 128 + m * 16) * 1024 + col0 + bj * 128; pwv[m][bj] = *(const u32x4*)(pe + off); xwv[m][bj] = *(const u32x4*)(x2b + off); } }
#pragma unroll
            for (int m = mb; m < mb + 2; ++m) {
                const int row = row0 + ai * 128 + m * 16; const float r = rv[m]; float ss = 0.f;
#pragma unroll
                for (int bj = 0; bj < 2; ++bj) {
                    const size_t off = (size_t)row * 1024 + col0 + bj * 128;
                    const u32x4 pw = pwv[m][bj], xw = xwv[m][bj];
                    const f32x4 x0 = (f32x4){bf_lo(xw.x), bf_hi(xw.x), bf_lo(xw.y), bf_hi(xw.y)}, x1 = (f32x4){bf_lo(xw.z), bf_hi(xw.z), bf_lo(xw.w), bf_hi(xw.w)};
                    const f32x4 a0 = acc[ai][bj][m][0], a1 = acc[ai][bj][m][1];
                    f32x4 o0, o1;
                    o0[0] = x0[0] + bf_lo(pw.x) * fast_sigmoid(a0[0] * r); o0[1] = x0[1] + bf_hi(pw.x) * fast_sigmoid(a0[1] * r);
                    o0[2] = x0[2] + bf_lo(pw.y) * fast_sigmoid(a0[2] * r); o0[3] = x0[3] + bf_hi(pw.y) * fast_sigmoid(a0[3] * r);
                    o1[0] = x1[0] + bf_lo(pw.z) * fast_sigmoid(a1[0] * r); o1[1] = x1[1] + bf_hi(pw.z) * fast_sigmoid(a1[1] * r);
                    o1[2] = x1[2] + bf_lo(pw.w) * fast_sigmoid(a1[2] * r); o1[3] = x1[3] + bf_hi(pw.w) * fast_sigmoid(a1[3] * r);
                    *(u32x4*)(x3b + off) = (u32x4){cvt_pk_bf16(o0[0], o0[1]), cvt_pk_bf16(o0[2], o0[3]), cvt_pk_bf16(o1[0], o1[1]), cvt_pk_bf16(o1[2], o1[3])};
                    ss += ((o0[0] * o0[0] + o0[1] * o0[1]) + (o0[2] * o0[2] + o0[3] * o0[3])) + ((o1[0] * o1[0] + o1[1] * o1[1]) + (o1[2] * o1[2] + o1[3] * o1[3]));
                }
                ss += __shfl_xor(ss, 16); ss += __shfl_xor(ss, 32);
                if (fq == 0) atomicAdd(rowsq + row, (unsigned)(ss * RSQ_FIX + 0.5f));
            }
        }
    }
};

__device__ __forceinline__ int t5_bucket(int rel) {
    const int n = rel < 0 ? -rel : rel; int bkt;
    if (n < 8) bkt = n; else { const int lg = 31 - __clz(n * n); int l = 8 + lg - 6; bkt = l > 15 ? 15 : l; }
    return bkt + (rel > 0 ? 16 : 0);
}
__device__ __forceinline__ void prep_transpose(const float* W, int K, int Nsrc, int col0, int ncols, const float* gk, bf16_t* out, LAS float* tile) {
    const int ntk = K / 64, ntn = ncols / 64;
    for (int t = BIDX(); t < ntk * ntn; t += gridDim.x) {
        const int tk = t % ntk, tn = t / ntk;
        __syncthreads();
        for (int e = TIDX(); e < 4096; e += 512) { const int r = e >> 6, c = e & 63;
            tile[r * 65 + c] = W[(size_t)(tk * 64 + r) * Nsrc + col0 + tn * 64 + c] * (gk ? gk[tk * 64 + r] : 1.f); }
        __syncthreads();
        for (int e = TIDX(); e < 4096; e += 512) { const int r = e >> 6, c = e & 63;
            out[(size_t)(tn * 64 + r) * K + tk * 64 + c] = f2bf(tile[c * 65 + r]); }
    }
}
__device__ __forceinline__ void phase_prep(const Params& P, LAS unsigned char* lds) {
    LAS float* tile = (LAS float*)lds;
    unsigned char* ws = P.ws;
    const size_t gtid = (size_t)BIDX() * 512 + TIDX(), gstride = (size_t)gridDim.x * 512;
    bf16_t* WinT = (bf16_t*)(ws + WS_WIN);
    prep_transpose(P.in[IN_WIN], 1024, 5152, 0, 3072, P.in[IN_N1G], WinT, tile);
    prep_transpose(P.in[IN_WIN], 1024, 5152, 3104, 2048, P.in[IN_N1G], WinT + (size_t)3584 * 1024, tile);
    prep_transpose(P.in[IN_WUPA], 512, 1024, 0, 1024, nullptr, (bf16_t*)(ws + WS_WUP), tile);
    prep_transpose(P.in[IN_WUPB], 512, 1024, 0, 1024, nullptr, (bf16_t*)(ws + WS_WUP) + (size_t)1024 * 512, tile);
    prep_transpose(P.in[IN_WOUT], 1024, 1024, 0, 1024, nullptr, (bf16_t*)(ws + WS_WOUT), tile);
    prep_transpose(P.in[IN_WQ], 1024, 2048, 0, 2048, P.in[IN_N2G], (bf16_t*)(ws + WS_WQ), tile);
    prep_transpose(P.in[IN_PLEG], 1024, 1024, 0, 1024, P.in[IN_N3G], (bf16_t*)(ws + WS_WGATE), tile);
    prep_transpose(P.in[IN_PLEW], 256, 1024, 0, 1024, nullptr, (bf16_t*)(ws + WS_WPLE), tile);
    { const float* win = P.in[IN_WIN]; const float* aw = P.in[IN_AW]; const float* g1 = P.in[IN_N1G];
      for (size_t i = gtid; i < (size_t)512 * 1024; i += gstride) { const int n = (int)(i >> 10), k = (int)(i & 1023), j = n >> 8, c = n & 255;
          const float* wr_ = win + (size_t)k * 5152 + 3072 + 16 * j; const float* ar = aw + (size_t)(j * 16) * 256 + c; float s = 0.f;
#pragma unroll
          for (int r = 0; r < 16; ++r) s += wr_[r] * ar[r * 256];
          WinT[(size_t)(3072 + n) * 1024 + k] = f2bf(s * g1[k]); } }
    { const float* sk = P.in[IN_SK]; bf16_t* o = (bf16_t*)(ws + WS_SK);
      for (size_t i = gtid; i < (size_t)262144 / 4; i += gstride) { const f32x4 v = ((const f32x4*)sk)[i]; u32x2 w; w.x = cvt_pk_bf16(v[0], v[1]); w.y = cvt_pk_bf16(v[2], v[3]); ((u32x2*)o)[i] = w; } }
    { const float* pu = P.in[IN_PU]; const float* pv = P.in[IN_PV]; const float* g2 = P.in[IN_N2G]; unsigned* ub = (unsigned*)(ws + WS_UB); unsigned* vb = (unsigned*)(ws + WS_VB);
      for (size_t i0 = gtid; i0 < (size_t)16384 * 1024 / 16; i0 += gstride) {
          f32x4 ua[2][2], va[2][2];
#pragma unroll
          for (int k = 0; k < 2; ++k) { const size_t i = i0 + k * ((size_t)16384 * 1024 / 16);
              ua[k][0] = ((const f32x4*)pu)[2 * i]; ua[k][1] = ((const f32x4*)pu)[2 * i + 1]; va[k][0] = ((const f32x4*)pv)[2 * i]; va[k][1] = ((const f32x4*)pv)[2 * i + 1]; }
#pragma unroll
          for (int k = 0; k < 2; ++k) { const size_t i = i0 + k * ((size_t)16384 * 1024 / 16); const int d = (int)((i * 8) & 1023);
              const f32x4 g0 = *(const f32x4*)(g2 + d), g1 = *(const f32x4*)(g2 + d + 4); const f32x4 a0 = ua[k][0] * g0 * U_SCALE, a1 = ua[k][1] * g1 * U_SCALE;
              unsigned w = 0u;
#pragma unroll
              for (int j = 0; j < 4; ++j) { const int q0 = (int)__builtin_rintf(fminf(fmaxf(a0[j], -8.f), 7.f)) & 15, q1 = (int)__builtin_rintf(fminf(fmaxf(a1[j], -8.f), 7.f)) & 15;
                  w |= (unsigned)q0 << (4 * j); w |= (unsigned)q1 << (16 + 4 * j); }
              ub[i] = w;
              f32x4 b0 = va[k][0] * V_SCALE, b1 = va[k][1] * V_SCALE;
#pragma unroll
              for (int j = 0; j < 4; ++j) { b0[j] = fminf(fmaxf(b0[j], -6.f), 6.f); b1[j] = fminf(fmaxf(b1[j], -6.f), 6.f); }
              unsigned w2 = 0u;
              w2 = __builtin_amdgcn_cvt_scalef32_pk_fp4_f32(w2, b0[0], b0[1], 1.0f, 0); w2 = __builtin_amdgcn_cvt_scalef32_pk_fp4_f32(w2, b0[2], b0[3], 1.0f, 1);
              w2 = __builtin_amdgcn_cvt_scalef32_pk_fp4_f32(w2, b1[0], b1[1], 1.0f, 2); w2 = __builtin_amdgcn_cvt_scalef32_pk_fp4_f32(w2, b1[2], b1[3], 1.0f, 3);
              vb[i] = w2; } } }
    if (BIDX() == 0) {
        float* sm = (float*)(ws + WS_SMALL);
        for (int i = TIDX(); i < 4 * 257; i += 512) { const int h = i / 257, e = i % 257; sm[h * 260 + e] = P.in[IN_RELB][t5_bucket(e - 128) * 4 + h] * LOG2E; }
        if (TIDX() < 64) { const float* lq = P.in[IN_LQK]; const int l = TIDX();
            const float a = wave_sum(lq[l] * lq[64 + l]), b = wave_sum(lq[128 + l] * lq[192 + l]);
            if (l == 0) sm[SM_LAM] = __expf(a) - __expf(b) + 0.2f; }
    }
}

__device__ __forceinline__ void phase_conv(const Params& P, int g) {
    const int lane = TIDX() & 63, gw = BIDX() * 8 + (TIDX() >> 6), NGW = gridDim.x * 8;
    const float* x = P.in[IN_XP + g]; const float* pp = P.in[IN_PP + g];
    bf16_t* xb = (bf16_t*)(P.ws + A_XBK); bf16_t* pb = (bf16_t*)(P.ws + A_PB); float* rowf = (float*)(P.ws + WS_ROW);
    for (int row0 = gw * 4; row0 < TG; row0 += NGW * 4) {
        f32x4 v[4][4], pv[4];
#pragma unroll
        for (int rr = 0; rr < 4; ++rr) { const f32x4* xr = (const f32x4*)(x + (size_t)(row0 + rr) * 1024) + lane;
#pragma unroll
            for (int j = 0; j < 4; ++j) v[rr][j] = xr[64 * j];
            pv[rr] = ((const f32x4*)(pp + (size_t)(row0 + rr) * 256))[lane]; }
#pragma unroll
        for (int rr = 0; rr < 4; ++rr) { const int row = row0 + rr; float ss = 0.f;
#pragma unroll
            for (int j = 0; j < 4; ++j) ss += (v[rr][j][0] * v[rr][j][0] + v[rr][j][1] * v[rr][j][1]) + (v[rr][j][2] * v[rr][j][2] + v[rr][j][3] * v[rr][j][3]);
            ss = wave_sum(ss);
            u32x2* o = (u32x2*)(xb + (size_t)row * 1024) + lane;
#pragma unroll
            for (int j = 0; j < 4; ++j) { u32x2 w; w.x = cvt_pk_bf16(v[rr][j][0], v[rr][j][1]); w.y = cvt_pk_bf16(v[rr][j][2], v[rr][j][3]); o[64 * j] = w; }
            u32x2 w; w.x = cvt_pk_bf16(pv[rr][0], pv[rr][1]); w.y = cvt_pk_bf16(pv[rr][2], pv[rr][3]);
            ((u32x2*)(pb + (size_t)row * 256))[lane] = w;
            if (lane == 0) { rowf[row] = rsqrtf(ss * (1.f / 1024.f) + EPS); rowf[TG + row] = 0.f; rowf[(3 + g) * TG + row] = 0.f; } }
    }
}

__device__ __forceinline__ float dot2p(unsigned a, unsigned b_pinned, float acc) { asm("" : "+v"(a)); return __builtin_amdgcn_fdot2_f32_bf16(__builtin_bit_cast(bf16x2_t, a), __builtin_bit_cast(bf16x2_t, b_pinned), acc, false); }
__device__ __forceinline__ float dot2w(unsigned a, unsigned b, float acc) { asm("" : "+v"(a)); asm("" : "+v"(b)); return __builtin_amdgcn_fdot2_f32_bf16(__builtin_bit_cast(bf16x2_t, a), __builtin_bit_cast(bf16x2_t, b), acc, false); }

#define ATT_MX3(a, b, c) __builtin_fmaxf(__builtin_fmaxf((a), (b)), (c))
constexpr int ATT_BUF = 32768, ATT_K1 = 0, ATT_K2 = 4096, ATT_V = 16384, ATT_BIAS = 98304, ATT_WS = 99584, ATT_X = 0;
__device__ __forceinline__ void attn_unit(const Params& P, int g, int b, int h, int qb, LAS unsigned char* lds) {
    const int S = g ? 2048 : 4096;
    const int tid = TIDX(), lane = tid & 63, r32 = lane & 31, hi = lane >> 5, wid = __builtin_amdgcn_readfirstlane(tid >> 6), wq = wid & 3, half = wid >> 2;
    const size_t rowbase = (size_t)b * S;
    const unsigned char* Q = P.ws + A_QA + rowbase * 512 + h * 128;
    const unsigned char* K = P.ws + A_KA + rowbase * 512 + h * 128;
    const bf16_t* V = (const bf16_t*)(P.ws + A_VA) + rowbase * 512 + h * 128;
    bf16_t* OA = (bf16_t*)(P.ws + A_OA) + rowbase * 512 + h * 128;
    const float* sm = (const float*)(P.ws + WS_SMALL);
    const int q0 = qb * 128 + wq * 32;
    LAS float* btab = (LAS float*)(lds + ATT_BIAS);
    LAS float* wsf = (LAS float*)(lds + ATT_WS) + wid * 64;
    const unsigned char* ksrc = K + (size_t)(tid >> 3) * 512 + (tid & 7) * 16;
    const bf16_t* vsrc = V + (size_t)(tid >> 4) * 512 + (tid & 15) * 8;
    const int kdst = ((tid & 7) >> 2) * ATT_K2 + (tid >> 3) * 64 + (((tid & 3) ^ ((tid >> 5) & 1)) << 4);
    const int vdst = ATT_V + ((tid & 15) >> 2) * 4096 + (tid >> 4) * 64 + (tid & 3) * 16;
    u32x4 kr0, vr0, vr1;
    kr0 = *(const u32x4*)ksrc; vr0 = *(const u32x4*)vsrc; vr1 = *(const u32x4*)(vsrc + 32 * 512);
    __syncthreads();
    if (tid < 257) btab[tid] = sm[h * 260 + tid];
    *(LAS u32x4*)(lds + kdst) = kr0; *(LAS u32x4*)(lds + vdst) = vr0; *(LAS u32x4*)(lds + vdst + 32 * 64) = vr1;
    i32x8 q;
    { const unsigned char* qrow = Q + (size_t)(q0 + r32) * 512 + half * 64 + 32 * hi; const u32x4 qa = *(const u32x4*)qrow, qb_ = *(const u32x4*)(qrow + 16);
      q = (i32x8){(int)qa.x, (int)qa.y, (int)qa.z, (int)qa.w, (int)qb_.x, (int)qb_.y, (int)qb_.z, (int)qb_.w}; }
    f32x16 o[4];
#pragma unroll
    for (int dq = 0; dq < 4; ++dq)
#pragma unroll
        for (int r = 0; r < 16; ++r) o[dq][r] = 0.f;
    float m = 0.f, l = 0.f;
    unsigned ones2 = 0x3F803F80u; asm volatile("" : "+v"(ones2));
    const int NT = S / 64;
    const int vp_off = ATT_V + ((lane >> 4) & 1) * 32 + (lane & 3) * 8 + (4 * hi + ((lane & 15) >> 2)) * 64;
    const int kp_base = (half ? ATT_K2 : ATT_K1) + r32 * 64, ksw = (r32 >> 2) & 1;
    u32x4 pw[4];
    pw[0] = pw[1] = pw[2] = pw[3] = (u32x4){0u, 0u, 0u, 0u};
#define ATT_PV(BUFP) do { LAS const unsigned char* vb_ = (BUFP); \
        _Pragma("unroll") for (int dh = 0; dh < 2; ++dh) { s16x4 vl[2][4], vh[2][4]; \
            _Pragma("unroll") for (int d2 = 0; d2 < 2; ++d2) _Pragma("unroll") for (int s = 0; s < 4; ++s) { vl[d2][s] = lds_tr(vb_ + vp_off + (2 * dh + d2) * 4096 + s * 1024); vh[d2][s] = lds_tr(vb_ + vp_off + (2 * dh + d2) * 4096 + s * 1024 + 512); } \
            __builtin_amdgcn_sched_barrier(0); \
            _Pragma("unroll") for (int d2 = 0; d2 < 2; ++d2) _Pragma("unroll") for (int s = 0; s < 4; ++s) { \
                const bf16x8 vf = (bf16x8){vl[d2][s][0], vl[d2][s][1], vl[d2][s][2], vl[d2][s][3], vh[d2][s][0], vh[d2][s][1], vh[d2][s][2], vh[d2][s][3]}; \
                o[2 * dh + d2] = MFMA32(__builtin_bit_cast(bf16x8, pw[s]), vf, o[2 * dh + d2]); } } } while (0)
    __syncthreads();
    int slot_c = 0, slot_p = 2, slot_n = 1;
    PLACE_PAD(0);
    for (int t = 0; t < NT; ++t) {
        LAS const unsigned char* buf = lds + slot_c * ATT_BUF;
        const bool more = t + 1 < NT;
        if (more) { const size_t adv = (size_t)(t + 1) * 64 * 512;
            kr0 = *(const u32x4*)(ksrc + adv); vr0 = *(const u32x4*)(vsrc + adv); vr1 = *(const u32x4*)(vsrc + adv + 32 * 512); }
        if (half && t > 0) ATT_PV(lds + slot_p * ATT_BUF);
        const int k0 = t * 64;
        const int relmin = k0 - (q0 + 31), relmax = k0 + 63 - q0;
        const int bmode = (relmax <= -91) ? 0 : (relmin >= 91 ? 2 : 1);
        float cb = 0.f;
        if (bmode != 1) cb = (bmode == 0) ? btab[0] : btab[256];
        const float nsub = cb - m;
        f32x16 sA, sB;
#pragma unroll
        for (int r = 0; r < 16; ++r) { sA[r] = nsub; sB[r] = nsub; }
        { const int c0 = ((2 * hi) ^ ksw) << 4, c1 = ((2 * hi + 1) ^ ksw) << 4;
          const u32x4 a0 = *(const LAS u32x4*)(buf + kp_base + c0), a1 = *(const LAS u32x4*)(buf + kp_base + c1), b0 = *(const LAS u32x4*)(buf + kp_base + 2048 + c0), b1 = *(const LAS u32x4*)(buf + kp_base + 2048 + c1);
          __builtin_amdgcn_sched_barrier(0);
          const i32x8 ka = {(int)a0.x, (int)a0.y, (int)a0.z, (int)a0.w, (int)a1.x, (int)a1.y, (int)a1.z, (int)a1.w}, kc = {(int)b0.x, (int)b0.y, (int)b0.z, (int)b0.w, (int)b1.x, (int)b1.y, (int)b1.z, (int)b1.w};
          sA = MFMA_F8(ka, q, sA); sB = MFMA_F8(kc, q, sB); }
        if (bmode == 1) {
            const int relbase = k0 - (q0 + r32);
#pragma unroll
            for (int r = 0; r < 16; ++r) { const int rel = relbase + crow(r, hi);
                const int i0 = min(max(rel, -128), 128) + 128, i1 = min(max(rel + 32, -128), 128) + 128;
                sA[r] += btab[i0]; sB[r] += btab[i1]; }
        }
        if (t == 0 || (t & 3) == 1 || bmode == 1) {
            float mx;
            { float xa = ATT_MX3(sA[0], sA[1], sB[0]), xb = ATT_MX3(sA[2], sA[3], sB[1]); xa = ATT_MX3(xa, sB[2], sB[3]);
#pragma unroll
              for (int r = 4; r < 16; r += 4) { xa = ATT_MX3(xa, sA[r], sA[r + 1]); xb = ATT_MX3(xb, sA[r + 2], sA[r + 3]); xa = ATT_MX3(xa, sB[r], sB[r + 1]); xb = ATT_MX3(xb, sB[r + 2], sB[r + 3]); }
              mx = __builtin_fmaxf(xa, xb); }
            mx = __builtin_fmaxf(mx, __shfl_xor(mx, 32));
            if (t == 0 || __any(mx > 8.f)) {
                const float dl = (t == 0) ? mx : fmaxf(mx, 0.f); m += dl;
                if (t != 0) { const float f = fast_exp2(-dl); l *= f;
                    if (hi == 0) wsf[r32] = f;
                    asm volatile("s_waitcnt lgkmcnt(0)" ::: "memory");
#pragma unroll
                    for (int r = 0; r < 16; ++r) { const float fr_ = wsf[crow(r, hi)];
#pragma unroll
                        for (int dq = 0; dq < 4; ++dq) o[dq][r] *= fr_; } }
#pragma unroll
                for (int r = 0; r < 16; ++r) { sA[r] -= dl; sB[r] -= dl; }
            }
        }
#pragma unroll
        for (int r = 0; r < 16; ++r) { sA[r] = fast_exp2(sA[r]); sB[r] = fast_exp2(sB[r]); }
        pw[0] = (u32x4){cvt_pk_bf16(sA[0], sA[1]), cvt_pk_bf16(sA[2], sA[3]), cvt_pk_bf16(sA[4], sA[5]), cvt_pk_bf16(sA[6], sA[7])};
        pw[1] = (u32x4){cvt_pk_bf16(sA[8], sA[9]), cvt_pk_bf16(sA[10], sA[11]), cvt_pk_bf16(sA[12], sA[13]), cvt_pk_bf16(sA[14], sA[15])};
        pw[2] = (u32x4){cvt_pk_bf16(sB[0], sB[1]), cvt_pk_bf16(sB[2], sB[3]), cvt_pk_bf16(sB[4], sB[5]), cvt_pk_bf16(sB[6], sB[7])};
        pw[3] = (u32x4){cvt_pk_bf16(sB[8], sB[9]), cvt_pk_bf16(sB[10], sB[11]), cvt_pk_bf16(sB[12], sB[13]), cvt_pk_bf16(sB[14], sB[15])};
        { float sa_ = 0.f, sb_ = 0.f;
#pragma unroll
          for (int w4 = 0; w4 < 4; ++w4) { sa_ = dot2p(pw[w4].x, ones2, sa_); sb_ = dot2p(pw[w4].y, ones2, sb_); sa_ = dot2p(pw[w4].z, ones2, sa_); sb_ = dot2p(pw[w4].w, ones2, sb_); }
          l += sa_ + sb_; }
        if (!half) ATT_PV(buf);
        if (more) { LAS unsigned char* nb = lds + slot_n * ATT_BUF;
            *(LAS u32x4*)(nb + kdst) = kr0; *(LAS u32x4*)(nb + vdst) = vr0; *(LAS u32x4*)(nb + vdst + 32 * 64) = vr1; }
        __syncthreads();
        { const int tmp = slot_p; slot_p = slot_c; slot_c = slot_n; slot_n = tmp; }
    }
    PLACE_PAD(0);
    if (half) ATT_PV(lds + slot_p * ATT_BUF);
#undef ATT_PV
    l += __shfl_xor(l, 32);
    if (hi == 0) wsf[r32] = (half ? sm[SM_LAM] : 1.f) / l;
    asm volatile("s_waitcnt lgkmcnt(0)" ::: "memory");
    LAS float* xch = (LAS float*)(lds + ATT_X) + wq * (32 * 132);
#pragma unroll
    for (int r = 0; r < 16; ++r) { const float a = wsf[crow(r, hi)];
#pragma unroll
        for (int dq = 0; dq < 4; ++dq) o[dq][r] *= a; }
    __syncthreads();
    if (half) {
#pragma unroll
        for (int r = 0; r < 16; ++r)
#pragma unroll
            for (int dq = 0; dq < 4; ++dq) xch[crow(r, hi) * 132 + 32 * dq + r32] = o[dq][r];
    }
    __syncthreads();
    if (!half) {
        const float* dag = P.in[IN_DAG];
        float gq[4];
#pragma unroll
        for (int dq = 0; dq < 4; ++dq) gq[dq] = dag[32 * dq + r32] * 0.8f;
#pragma unroll
        for (int r = 0; r < 16; ++r) {
            float ov[4]; float ss = 0.f;
#pragma unroll
            for (int dq = 0; dq < 4; ++dq) { ov[dq] = o[dq][r] - xch[crow(r, hi) * 132 + 32 * dq + r32]; ss += ov[dq] * ov[dq]; }
#pragma unroll
            for (int of_ = 1; of_ < 32; of_ <<= 1) ss += __shfl_xor(ss, of_);
            const float sc = rsqrtf(ss * (1.f / 128.f) + EPS);
            bf16_t* orow = OA + (size_t)(q0 + crow(r, hi)) * 512 + r32;
#pragma unroll
            for (int dq = 0; dq < 4; ++dq) orow[32 * dq] = f2bf(ov[dq] * sc * gq[dq]);
        }
    }
}

constexpr int G_Q = 0, G_KE = 9216, G_KDT = 18432, G_ATT = 27648, G_V = 36864, G_DEC = 55296;
__device__ __forceinline__ float wave_prefix_sum(float v) {
    v += __builtin_bit_cast(float, __builtin_amdgcn_update_dpp(0, __builtin_bit_cast(int, v), 0x111, 0xf, 0xf, true));
    v += __builtin_bit_cast(float, __builtin_amdgcn_update_dpp(0, __builtin_bit_cast(int, v), 0x112, 0xf, 0xf, true));
    v += __builtin_bit_cast(float, __builtin_amdgcn_update_dpp(0, __builtin_bit_cast(int, v), 0x114, 0xf, 0xf, true));
    v += __builtin_bit_cast(float, __builtin_amdgcn_update_dpp(0, __builtin_bit_cast(int, v), 0x118, 0xf, 0xf, true));
    v += __builtin_bit_cast(float, __builtin_amdgcn_update_dpp(0, __builtin_bit_cast(int, v), 0x142, 0xa, 0xf, false));
    v += __builtin_bit_cast(float, __builtin_amdgcn_update_dpp(0, __builtin_bit_cast(int, v), 0x143, 0xc, 0xf, false));
    return v;
}
__device__ __forceinline__ void gla_item(const Params& P, int g, int item, LAS unsigned char* lds) {
    const int S = g ? 2048 : 4096;
    const int dir = item & 1, h = (item >> 1) & 3, b = item >> 3;
    const int tid = TIDX(), lane = tid & 63, wid = tid >> 6, q4 = lane >> 4, l15 = lane & 15;
    const size_t rowbase = (size_t)b * S;
    const bf16_t* QG = (const bf16_t*)(P.ws + A_QG) + rowbase * 256 + h * 8 * 512;
    const bf16_t* KG = (const bf16_t*)(P.ws + A_KG) + rowbase * 256 + h * 8 * 512;
    const bf16_t* VG = (const bf16_t*)(P.ws + A_VG) + rowbase * 512 + h * 128;
    const bf16_t* LA = (const bf16_t*)(P.ws + A_LA) + rowbase * 512 + (dir * 32 + h * 8) * 512;
    bf16_t* OD = (bf16_t*)(P.ws + (dir ? A_OB : A_OF)) + rowbase * 512 + h * 128;
    LAS float* Ldec = (LAS float*)(lds + G_DEC);
    f32x4 st[4];
#pragma unroll
    for (int kb = 0; kb < 4; ++kb) st[kb] = (f32x4){0.f, 0.f, 0.f, 0.f};
    const int nc = S / 64;
    const int kc = wid * 8;
    u32x4 qv, kv, lav, vv[2];
#define GLA_ISSUE(cc) { const size_t tn = (size_t)(cc) * 64; \
        qv = *(const u32x4*)(QG + tn * 256 + (size_t)(kc >> 3) * 512 + lane * 8); kv = *(const u32x4*)(KG + tn * 256 + (size_t)(kc >> 3) * 512 + lane * 8); \
        lav = *(const u32x4*)(LA + tn * 512 + (size_t)(kc >> 3) * 512 + lane * 8); \
        _Pragma("unroll") for (int i = 0; i < 2; ++i) { const int pidx = tid + i * 512; vv[i] = *(const u32x4*)(VG + (tn + (pidx >> 4)) * 512 + (pidx & 15) * 8); } }
#define GLA_BAR { asm volatile("s_waitcnt lgkmcnt(0)" ::: "memory"); __builtin_amdgcn_s_barrier(); asm volatile("" ::: "memory"); }
    GLA_ISSUE(dir ? nc - 1 : 0)
    PLACE_PAD(0);
    for (int n = 0; n < nc; ++n) {
        const int c = dir ? (nc - 1 - n) : n; const size_t t0 = (size_t)c * 64;
        float la[8], bb[8], tot[8], qf[8], kf[8];
        la[0] = bf_lo(lav.x); la[1] = bf_hi(lav.x); la[2] = bf_lo(lav.y); la[3] = bf_hi(lav.y); la[4] = bf_lo(lav.z); la[5] = bf_hi(lav.z); la[6] = bf_lo(lav.w); la[7] = bf_hi(lav.w);
#pragma unroll
        for (int j = 0; j < 8; ++j) { const float pre = wave_prefix_sum(la[j]);
            tot[j] = __builtin_bit_cast(float, __builtin_amdgcn_readlane(__builtin_bit_cast(int, pre), 63));
            bb[j] = dir == 0 ? pre : tot[j] - pre + la[j]; }
        qf[0] = bf_lo(qv.x); qf[1] = bf_hi(qv.x); qf[2] = bf_lo(qv.y); qf[3] = bf_hi(qv.y); qf[4] = bf_lo(qv.z); qf[5] = bf_hi(qv.z); qf[6] = bf_lo(qv.w); qf[7] = bf_hi(qv.w);
        kf[0] = bf_lo(kv.x); kf[1] = bf_hi(kv.x); kf[2] = bf_lo(kv.y); kf[3] = bf_hi(kv.y); kf[4] = bf_lo(kv.z); kf[5] = bf_hi(kv.z); kf[6] = bf_lo(kv.w); kf[7] = bf_hi(kv.w);
        float qe[8], ke[8], kd[8];
#pragma unroll
        for (int j = 0; j < 8; ++j) { qe[j] = qf[j] * __expf(bb[j]); ke[j] = kf[j] * __expf(-bb[j]); kd[j] = kf[j] * __expf(tot[j] - bb[j]); }
        GLA_BAR
#pragma unroll
        for (int i = 0; i < 2; ++i) { const int pidx = tid + i * 512; *(LAS u32x4*)(lds + G_V + (pidx >> 4) * 288 + (pidx & 15) * 16) = vv[i]; }
#pragma unroll
        for (int j = 0; j < 8; ++j) *(LAS bf16_t*)(lds + G_KDT + (kc + j) * 144 + lane * 2) = f2bf(kd[j]);
        *(LAS u32x4*)(lds + G_Q + lane * 144 + kc * 2) = (u32x4){cvt_pk_bf16(qe[0], qe[1]), cvt_pk_bf16(qe[2], qe[3]), cvt_pk_bf16(qe[4], qe[5]), cvt_pk_bf16(qe[6], qe[7])};
        *(LAS u32x4*)(lds + G_KE + lane * 144 + kc * 2) = (u32x4){cvt_pk_bf16(ke[0], ke[1]), cvt_pk_bf16(ke[2], ke[3]), cvt_pk_bf16(ke[4], ke[5]), cvt_pk_bf16(ke[6], ke[7])};
        if (lane < 8) { float tj = tot[0];
#pragma unroll
            for (int j = 1; j < 8; ++j) tj = lane == j ? tot[j] : tj;
            Ldec[kc + lane] = __expf(tj); }
        if (n + 1 < nc) GLA_ISSUE(dir ? (nc - 2 - n) : (n + 1))
        GLA_BAR
        { const int tb = wid >> 1;
#pragma unroll
          for (int i = 0; i < 2; ++i) { const int sb = (wid & 1) * 2 + i; f32x4 acc = (f32x4){0.f, 0.f, 0.f, 0.f};
#pragma unroll
              for (int ks = 0; ks < 2; ++ks) {
                  const bf16x8 af = *(const LAS bf16x8*)(lds + G_Q + (16 * tb + l15) * 144 + (32 * ks + 8 * q4) * 2);
                  const bf16x8 bf = *(const LAS bf16x8*)(lds + G_KE + (16 * sb + l15) * 144 + (32 * ks + 8 * q4) * 2);
                  acc = MFMA16(af, bf, acc); }
              const int s_ = 16 * sb + l15;
#pragma unroll
              for (int r = 0; r < 4; ++r) { const int t_ = 16 * tb + 4 * q4 + r; const bool keep = dir == 0 ? (s_ <= t_) : (s_ > t_);
                  *(LAS bf16_t*)(lds + G_ATT + t_ * 144 + s_ * 2) = f2bf(keep ? acc[r] : 0.f); } } }
        GLA_BAR
        bf16x8 vf[2];
#pragma unroll
        for (int ks = 0; ks < 2; ++ks) { LAS const unsigned char* ap = lds + G_V + (32 * ks + 8 * q4 + (l15 >> 2)) * 288 + (16 * wid + (l15 & 3) * 4) * 2;
            const s16x4 lo = lds_tr(ap), hi4 = lds_tr(ap + 4 * 288); vf[ks] = (bf16x8){lo[0], lo[1], lo[2], lo[3], hi4[0], hi4[1], hi4[2], hi4[3]}; }
        bf16x8 sf[2];
#pragma unroll
        for (int ks = 0; ks < 2; ++ks) { const u32x4 w = (u32x4){cvt_pk_bf16(st[2 * ks][0], st[2 * ks][1]), cvt_pk_bf16(st[2 * ks][2], st[2 * ks][3]), cvt_pk_bf16(st[2 * ks + 1][0], st[2 * ks + 1][1]), cvt_pk_bf16(st[2 * ks + 1][2], st[2 * ks + 1][3])};
            sf[ks] = __builtin_bit_cast(bf16x8, w); }
#pragma unroll
        for (int tb = 0; tb < 4; ++tb) { f32x4 acc = (f32x4){0.f, 0.f, 0.f, 0.f};
#pragma unroll
            for (int ks = 0; ks < 2; ++ks) { const bf16x8 af = *(const LAS bf16x8*)(lds + G_ATT + (16 * tb + l15) * 144 + (32 * ks + 8 * q4) * 2); acc = MFMA16(vf[ks], af, acc); }
#pragma unroll
            for (int ks = 0; ks < 2; ++ks) { const s16x4 a0 = *(const LAS s16x4*)(lds + G_Q + (16 * tb + l15) * 144 + (32 * ks + 4 * q4) * 2), a1 = *(const LAS s16x4*)(lds + G_Q + (16 * tb + l15) * 144 + (32 * ks + 16 + 4 * q4) * 2);
                const bf16x8 af = (bf16x8){a0[0], a0[1], a0[2], a0[3], a1[0], a1[1], a1[2], a1[3]}; acc = MFMA16(sf[ks], af, acc); }
            *(u32x2*)(OD + (t0 + 16 * tb + l15) * 512 + 16 * wid + 4 * q4) = (u32x2){cvt_pk_bf16(acc[0], acc[1]), cvt_pk_bf16(acc[2], acc[3])}; }
#pragma unroll
        for (int kb = 0; kb < 4; ++kb) { const f32x4 dc = *(const LAS f32x4*)(Ldec + 16 * kb + 4 * q4); st[kb] = st[kb] * dc;
#pragma unroll
            for (int ks = 0; ks < 2; ++ks) { const bf16x8 af = *(const LAS bf16x8*)(lds + G_KDT + (16 * kb + l15) * 144 + (32 * ks + 8 * q4) * 2); st[kb] = MFMA16(af, vf[ks], st[kb]); } }
    }
}
constexpr size_t WS_QUEUE = 16384;
__device__ __forceinline__ void phase_mix(const Params& P, int g, LAS unsigned char* lds) {
    const int B = g ? 16 : 8, S = g ? 2048 : 4096; const int nG = B * 8, nQ = S / 128, nA = B * 4 * nQ;
    const int G = gridDim.x, bx = BIDX();
    for (int i = bx; i < nG; i += G) gla_item(P, g, i, lds);
    unsigned* queues = (unsigned*)(P.ws + WS_CTL + WS_QUEUE) + g * 8 * 16;
    const int per_q = nA / 8;
    volatile LAS int* slot = (volatile LAS int*)(lds + LDSCTL_OFF + 64);
    int x = bx & 7, tries = 0;
    for (;;) {
        __syncthreads();
        if (threadIdx.x == 0) slot[0] = (int)__hip_atomic_fetch_add(queues + x * 16, 1u, __ATOMIC_RELAXED, __HIP_MEMORY_SCOPE_AGENT);
        __syncthreads();
        const int j = __builtin_amdgcn_readfirstlane(slot[0]);
        if (j >= per_q) { if (++tries == 8) break; x = (x + 1) & 7; continue; }
        const int bh = x + 8 * (j / nQ), qb = j % nQ;
        attn_unit(P, g, bh >> 2, bh & 3, qb, lds);
    }
}

__device__ __forceinline__ void phase_ogfix(const Params& P, int g) {
    const int lane = TIDX() & 63, gw = BIDX() * 8 + (TIDX() >> 6), NGW = gridDim.x * 8;
    const bf16_t* of = (const bf16_t*)(P.ws + A_OF); const bf16_t* ob = (const bf16_t*)(P.ws + A_OB); const bf16_t* rgs = (const bf16_t*)(P.ws + A_RGS); bf16_t* og = (bf16_t*)(P.ws + A_OG);
    const float* gg = P.in[IN_GLAG];
    float gv[8];
#pragma unroll
    for (int j = 0; j < 8; ++j) gv[j] = gg[(lane & 15) * 8 + j];
    for (int row0 = gw * 4; row0 < TG; row0 += NGW * 4) {
        u32x4 a4[4], b4[4], r4[4];
#pragma unroll
        for (int rr = 0; rr < 4; ++rr) { const size_t row = row0 + rr; a4[rr] = ((const u32x4*)(of + row * 512))[lane]; b4[rr] = ((const u32x4*)(ob + row * 512))[lane]; r4[rr] = ((const u32x4*)(rgs + row * 512))[lane]; }
#pragma unroll
        for (int rr = 0; rr < 4; ++rr) { const size_t row = row0 + rr; const u32x4 a = a4[rr], b = b4[rr], r = r4[rr];
            float v[8];
            v[0] = bf_lo(a.x) + bf_lo(b.x); v[1] = bf_hi(a.x) + bf_hi(b.x); v[2] = bf_lo(a.y) + bf_lo(b.y); v[3] = bf_hi(a.y) + bf_hi(b.y);
            v[4] = bf_lo(a.z) + bf_lo(b.z); v[5] = bf_hi(a.z) + bf_hi(b.z); v[6] = bf_lo(a.w) + bf_lo(b.w); v[7] = bf_hi(a.w) + bf_hi(b.w);
            float ss = 0.f;
#pragma unroll
            for (int j = 0; j < 8; ++j) ss += v[j] * v[j];
#pragma unroll
            for (int o = 1; o < 16; o <<= 1) ss += __shfl_xor(ss, o);
            const float sc = rsqrtf(ss * (1.f / 128.f) + EPS);
            const float rv[8] = {bf_lo(r.x), bf_hi(r.x), bf_lo(r.y), bf_hi(r.y), bf_lo(r.z), bf_hi(r.z), bf_lo(r.w), bf_hi(r.w)};
#pragma unroll
            for (int j = 0; j < 8; ++j) v[j] = v[j] * sc * gv[j] * rv[j];
            ((u32x4*)(og + row * 512))[lane] = (u32x4){cvt_pk_bf16(v[0], v[1]), cvt_pk_bf16(v[2], v[3]), cvt_pk_bf16(v[4], v[5]), cvt_pk_bf16(v[6], v[7])}; }
    }
}

__device__ __forceinline__ unsigned f2sort(float f) { const unsigned u = __float_as_uint(f); return (u & 0x80000000u) ? ~u : (u | 0x80000000u); }
__device__ __forceinline__ float sort2f(unsigned s) { const unsigned u = (s & 0x80000000u) ? (s & 0x7fffffffu) : ~s; return __uint_as_float(u); }
__device__ __forceinline__ void ce_desc(unsigned& a, unsigned& b) { const unsigned h = max(a, b), l = min(a, b); a = h; b = l; }
__device__ __forceinline__ void bitonic_merge16(unsigned (&a)[16]) {
#pragma unroll
    for (int j = 8; j > 0; j >>= 1)
#pragma unroll
        for (int i = 0; i < 16; ++i) { const int l = i ^ j; if (l > i) ce_desc(a[i], a[l]); }
}
__device__ __forceinline__ void bitonic_sort16(unsigned (&a)[16]) {
#define CE_(i, j) ce_desc(a[i], a[j]);
    CE_(0,13) CE_(1,12) CE_(2,15) CE_(3,14) CE_(4,8) CE_(5,6) CE_(7,11) CE_(9,10)
    CE_(0,5) CE_(1,7) CE_(2,9) CE_(3,4) CE_(6,13) CE_(8,14) CE_(10,15) CE_(11,12)
    CE_(0,1) CE_(2,3) CE_(4,5) CE_(6,8) CE_(7,9) CE_(10,11) CE_(12,13) CE_(14,15)
    CE_(0,2) CE_(1,3) CE_(4,10) CE_(5,11) CE_(6,7) CE_(8,9) CE_(12,14) CE_(13,15)
    CE_(1,2) CE_(3,12) CE_(4,6) CE_(5,7) CE_(8,10) CE_(9,11) CE_(13,14)
    CE_(1,4) CE_(2,6) CE_(5,8) CE_(7,10) CE_(9,13) CE_(11,14)
    CE_(2,4) CE_(3,6) CE_(9,12) CE_(11,13)
    CE_(3,5) CE_(6,8) CE_(7,9) CE_(10,12)
    CE_(3,4) CE_(5,6) CE_(7,8) CE_(9,10) CE_(11,12)
    CE_(6,7) CE_(8,9)
#undef CE_
}
__device__ __forceinline__ void top16_merge(unsigned (&L)[16], const unsigned (&N)[16]) {
#pragma unroll
    for (int i = 0; i < 16; ++i) L[i] = max(L[i], N[15 - i]);
    bitonic_merge16(L);
}
__device__ __forceinline__ void topk_half(const bf16x8 (&bq)[8], LAS const unsigned char* kp, int hi, unsigned (&L)[16]) {
#pragma unroll 1
    for (int kb = 0; kb < 4; ++kb) {
        f32x16 acc;
#pragma unroll
        for (int r = 0; r < 16; ++r) acc[r] = 0.f;
#pragma unroll
        for (int ks = 0; ks < 8; ++ks) { const bf16x8 ak = *(const LAS bf16x8*)(kp + ks * 4096 + kb * 512); acc = MFMA32(ak, bq[ks], acc); }
        unsigned N[16];
#pragma unroll
        for (int r = 0; r < 16; ++r) { const unsigned idx = 32 * kb + crow(r, hi); N[r] = (f2sort(acc[r]) & ~127u) | (127u - idx); }
        bitonic_sort16(N);
        if (kb == 0) {
#pragma unroll
            for (int r = 0; r < 16; ++r) L[r] = N[r];
        } else top16_merge(L, N);
    }
    unsigned O[16];
#pragma unroll
    for (int j = 0; j < 16; ++j) O[j] = __shfl_xor(L[j], 32);
    top16_merge(L, O);
}
__device__ __forceinline__ void phase_topk(const Params& P, int g, LAS unsigned char* lds) {
    const int tid = TIDX(), lane = tid & 63, r32 = lane & 31, hi = lane >> 5, wid = tid >> 6;
    const bf16_t* Q = (const bf16_t*)(P.ws + A_Q); const bf16_t* SK = (const bf16_t*)(P.ws + WS_SK);
    unsigned short* IDX = (unsigned short*)(P.ws + A_IDX); float* GW = (float*)(P.ws + A_GW);
    LAS unsigned char* sc = lds + 65536 + wid * 1024 + r32 * 32;
    const int G = gridDim.x, bx = BIDX(); const bool split = (G & 7) == 0;
    const int nworkers = (split ? G / 8 : G) * 8, worker = (split ? (bx >> 3) : bx) * 8 + wid;
  for (int hd = 0; hd < 8; ++hd) {
    if (split && (bx & 7) != hd) continue;
    __syncthreads();
    for (int e = tid; e < 4096; e += 512) { const int c = e >> 11, n = (e >> 4) & 127, ch = e & 15;
        *(LAS u32x4*)(lds + c * 32768 + ch * 2048 + n * 16) = *(const u32x4*)(SK + ((size_t)(hd * 2 + c) * 128 + n) * 128 + ch * 8); }
    __syncthreads();
    for (int tb = worker; tb < TG / 32; tb += nworkers) {
        const int tok0 = tb * 32;
        unsigned LA_[16], LB_[16];
        bf16x8 bqa[8], bqb[8];
        { const bf16_t* qp = Q + (size_t)(tok0 + r32) * 2048 + hd * 256 + 8 * hi;
#pragma unroll
          for (int ks = 0; ks < 8; ++ks) { bqa[ks] = *(const bf16x8*)(qp + 16 * ks); bqb[ks] = *(const bf16x8*)(qp + 128 + 16 * ks); } }
        topk_half(bqa, lds + hi * 2048 + r32 * 16, hi, LA_);
        topk_half(bqb, lds + 32768 + hi * 2048 + r32 * 16, hi, LB_);
        float va[16], vb[16];
#pragma unroll
        for (int j = 0; j < 16; ++j) { va[j] = sort2f(LA_[j] & ~127u); vb[j] = sort2f(LB_[j] & ~127u); }
        unsigned L2[16];
        {
            constexpr int NC = 50;
            constexpr unsigned char CI[64] = {0,0,0,0,0,0,0,0,0,0,0,0,0,0,0,0, 1,1,1,1,1,1,1,1, 2,2,2,2,2, 3,3,3,3, 4,4,4, 5,5, 6,6, 7,7, 8,9,10,11,12,13,14,15, 0,0,0,0,0,0,0,0,0,0,0,0,0,0};
            constexpr unsigned char CJ[64] = {0,1,2,3,4,5,6,7,8,9,10,11,12,13,14,15, 0,1,2,3,4,5,6,7, 0,1,2,3,4, 0,1,2,3, 0,1,2, 0,1, 0,1, 0,1, 0,0,0,0,0,0,0,0, 0,0,0,0,0,0,0,0,0,0,0,0,0,0};
#pragma unroll
            for (int gq = 0; gq < 4; ++gq) {
                unsigned N[16];
#pragma unroll
                for (int c = 0; c < 16; ++c) { const int ci = 16 * gq + c; N[c] = (ci < NC) ? ((f2sort(va[CI[ci]] + vb[CJ[ci]]) & ~255u) | (unsigned)(CI[ci] * 16 + CJ[ci])) : 0u; }
                bitonic_sort16(N);
                if (gq == 0) {
#pragma unroll
                    for (int c = 0; c < 16; ++c) L2[c] = N[c];
                } else top16_merge(L2, N);
            }
        }
        if (hi == 0) {
#pragma unroll
            for (int j = 0; j < 16; ++j) { sc[j] = (unsigned char)(127u - (LA_[j] & 127u)); sc[16 + j] = (unsigned char)(127u - (LB_[j] & 127u)); }
        }
        asm volatile("s_waitcnt lgkmcnt(0)" ::: "memory");
        float e[16]; float sum = 0.f; const float v0 = sort2f(L2[0] & ~255u);
#pragma unroll
        for (int k = 0; k < 16; ++k) { e[k] = __expf(sort2f(L2[k] & ~255u) - v0); sum += e[k]; }
        const float inv = 1.f / sum;
        const size_t ob = (size_t)(tok0 + r32) * 128 + hd * 16;
        if (hi == 0) {
            unsigned ids[16];
#pragma unroll
            for (int k = 0; k < 16; ++k) { const unsigned key = L2[k]; const int i = (key >> 4) & 15, j = key & 15; const unsigned ia = sc[i], ib = sc[16 + j]; ids[k] = ia * 128u + ib; }
            *(u32x4*)(IDX + ob) = (u32x4){ids[0] | (ids[1] << 16), ids[2] | (ids[3] << 16), ids[4] | (ids[5] << 16), ids[6] | (ids[7] << 16)};
            *(u32x4*)(IDX + ob + 8) = (u32x4){ids[8] | (ids[9] << 16), ids[10] | (ids[11] << 16), ids[12] | (ids[13] << 16), ids[14] | (ids[15] << 16)};
        } else {
#pragma unroll
            for (int k = 0; k < 4; ++k) *(f32x4*)(GW + ob + 4 * k) = (f32x4){e[4 * k] * inv, e[4 * k + 1] * inv, e[4 * k + 2] * inv, e[4 * k + 3] * inv};
        }
        asm volatile("s_waitcnt lgkmcnt(0)" ::: "memory");
    }
  }
}

constexpr int GQ_SCHED = 0, GQ_CNT = 4224, GQ_CUR = 4480, GQ_WAVE = 4736;
constexpr int GA_D = 4;
__device__ __forceinline__ float dpp_row_sum(float v) {
    v += __builtin_bit_cast(float, __builtin_amdgcn_update_dpp(0, __builtin_bit_cast(int, v), 0xB1, 0xf, 0xf, true));
    v += __builtin_bit_cast(float, __builtin_amdgcn_update_dpp(0, __builtin_bit_cast(int, v), 0x4E, 0xf, 0xf, true));
    v += __builtin_bit_cast(float, __builtin_amdgcn_update_dpp(0, __builtin_bit_cast(int, v), 0x141, 0xf, 0xf, true));
    v += __builtin_bit_cast(float, __builtin_amdgcn_update_dpp(0, __builtin_bit_cast(int, v), 0x140, 0xf, 0xf, true));
    return v;
}
__device__ __forceinline__ void phase_gather(const Params& P, int g, LAS unsigned char* lds) {
    const int tid = TIDX(), lane = tid & 63, wid = __builtin_amdgcn_readfirstlane(tid >> 6), q = lane >> 4, j = lane & 15;
    float* xo = P.out + (size_t)g * TG * 1024;
    const bf16_t* x1b = (const bf16_t*)(P.ws + A_X1B); bf16_t* x2b = (bf16_t*)(P.ws + A_X2B);
    const unsigned short* IDX = (const unsigned short*)(P.ws + A_IDX); const float* GW = (const float*)(P.ws + A_GW);
    const unsigned char* Ub = P.ws + WS_UB + j * 16; const unsigned char* Vb = P.ws + WS_VB + j * 16;
    float* rowf = (float*)(P.ws + WS_ROW);
    LAS unsigned char* wl = lds + wid * GQ_WAVE;
    LAS unsigned* cnt = (LAS unsigned*)(wl + GQ_CNT); LAS unsigned* cur = (LAS unsigned*)(wl + GQ_CUR);
    LAS u32x2* sched = (LAS u32x2*)(wl + GQ_SCHED) + q * 128;
    const int G = gridDim.x, b = BIDX();
    for (int bi = b; bi < TG / 32; bi += G) {
        const int tok = bi * 32 + wid * 4 + q;
        cnt[lane] = 0u;
        u32x4 ei = *(const u32x4*)(IDX + (size_t)tok * 128 + j * 8);
        f32x4 eg0 = *(const f32x4*)(GW + (size_t)tok * 128 + j * 8), eg1 = *(const f32x4*)(GW + (size_t)tok * 128 + j * 8 + 4);
        unsigned eidx[8]; float egt[8];
        eidx[0] = ei.x & 0xffffu; eidx[1] = ei.x >> 16; eidx[2] = ei.y & 0xffffu; eidx[3] = ei.y >> 16; eidx[4] = ei.z & 0xffffu; eidx[5] = ei.z >> 16; eidx[6] = ei.w & 0xffffu; eidx[7] = ei.w >> 16;
        egt[0] = eg0[0]; egt[1] = eg0[1]; egt[2] = eg0[2]; egt[3] = eg0[3]; egt[4] = eg1[0]; egt[5] = eg1[1]; egt[6] = eg1[2]; egt[7] = eg1[3];
        const float rs = rsqrtf((float)__float_as_uint(rowf[TG + tok]) * RSQ_INV * (1.f / 1024.f) + EPS) * (1.f / U_SCALE);
        asm volatile("s_waitcnt lgkmcnt(0)" ::: "memory");
#pragma unroll
        for (int k = 0; k < 8; ++k) __hip_atomic_fetch_add(cnt + (q * 16 + (eidx[k] >> 10)), 1u, __ATOMIC_RELAXED, __HIP_MEMORY_SCOPE_WORKGROUP);
        asm volatile("s_waitcnt lgkmcnt(0)" ::: "memory");
        { const unsigned c0 = cnt[lane]; unsigned incl = c0;
#pragma unroll
          for (int o = 1; o < 64; o <<= 1) { const unsigned t = __shfl_up(incl, o); if (lane >= o) incl += t; }
          cur[lane] = incl - c0; }
        asm volatile("s_waitcnt lgkmcnt(0)" ::: "memory");
#pragma unroll
        for (int k = 0; k < 8; ++k) { const unsigned pos = __hip_atomic_fetch_add(cur + (q * 16 + (eidx[k] >> 10)), 1u, __ATOMIC_RELAXED, __HIP_MEMORY_SCOPE_WORKGROUP);
            ((LAS u32x2*)(wl + GQ_SCHED))[pos] = (u32x2){eidx[k], __float_as_uint(egt[k] * (1.f / V_SCALE))}; }
        if (lane < 8) ((LAS u32x2*)(wl + GQ_SCHED))[512 + lane] = (u32x2){0u, 0u};
        asm volatile("s_waitcnt lgkmcnt(0)" ::: "memory");
        typedef _Float16 h16x2 __attribute__((ext_vector_type(2)));
        h16x2 acc[8][4];
#pragma unroll
        for (int c8 = 0; c8 < 8; ++c8)
#pragma unroll
            for (int c = 0; c < 4; ++c) acc[c8][c] = (h16x2){(_Float16)0.f, (_Float16)0.f};
        {
            int hq[8]; float hmaxv = 0.f; float hv[64];
            { const u32x4* row = (const u32x4*)(x1b + (size_t)tok * 1024 + 64 * j);
#pragma unroll
              for (int c8 = 0; c8 < 8; ++c8) { const u32x4 r = row[c8];
                  hv[8 * c8 + 0] = bf_lo(r.x); hv[8 * c8 + 1] = bf_hi(r.x); hv[8 * c8 + 2] = bf_lo(r.y); hv[8 * c8 + 3] = bf_hi(r.y); hv[8 * c8 + 4] = bf_lo(r.z); hv[8 * c8 + 5] = bf_hi(r.z); hv[8 * c8 + 6] = bf_lo(r.w); hv[8 * c8 + 7] = bf_hi(r.w); } }
#pragma unroll
            for (int c = 0; c < 64; ++c) hmaxv = fmaxf(hmaxv, fabsf(hv[c]));
            hmaxv = fmaxf(hmaxv, __builtin_bit_cast(float, __builtin_amdgcn_update_dpp(0, __builtin_bit_cast(int, hmaxv), 0xB1, 0xf, 0xf, true)));
            hmaxv = fmaxf(hmaxv, __builtin_bit_cast(float, __builtin_amdgcn_update_dpp(0, __builtin_bit_cast(int, hmaxv), 0x4E, 0xf, 0xf, true)));
            hmaxv = fmaxf(hmaxv, __builtin_bit_cast(float, __builtin_amdgcn_update_dpp(0, __builtin_bit_cast(int, hmaxv), 0x141, 0xf, 0xf, true)));
            hmaxv = fmaxf(hmaxv, __builtin_bit_cast(float, __builtin_amdgcn_update_dpp(0, __builtin_bit_cast(int, hmaxv), 0x140, 0xf, 0xf, true)));
            hmaxv = fmaxf(hmaxv, 1e-20f);
            const float hstep = 0.335f * __builtin_amdgcn_rcpf(rs * U_SCALE); const float hsc = __builtin_amdgcn_rcpf(hstep), rsq = rs * hstep;
#pragma unroll
            for (int c8 = 0; c8 < 8; ++c8) { unsigned w = 0u;
#pragma unroll
                for (int c = 0; c < 8; ++c) { const int qv = (int)__builtin_rintf(fminf(fmaxf(hv[8 * c8 + c] * hsc, -8.f), 7.f)); w |= (unsigned)(qv & 15) << (4 * c); }
                hq[c8] = (int)w; }
            const unsigned char* Ub4 = P.ws + WS_UB + j * 32; const unsigned char* Vb4 = P.ws + WS_VB + j * 32;
            u32x4 U[GA_D][2], V[GA_D][2];
#pragma unroll
            for (int d = 0; d < GA_D; ++d) { const size_t ro = (size_t)sched[d].x * 512; U[d][0] = ((const u32x4*)(Ub4 + ro))[0]; U[d][1] = ((const u32x4*)(Ub4 + ro))[1]; V[d][0] = ((const u32x4*)(Vb4 + ro))[0]; V[d][1] = ((const u32x4*)(Vb4 + ro))[1]; }
            PLACE_PAD(8);
#pragma unroll 1
            for (int k0 = 0; k0 < 128; k0 += GA_D) {
#pragma unroll
                for (int d = 0; d < GA_D; ++d) {
                    const float gate = __uint_as_float(sched[k0 + d].y);
                    const u32x4 u0 = U[d][0], u1 = U[d][1], v0 = V[d][0], v1 = V[d][1];
                    { const size_t ro = (size_t)sched[k0 + d + GA_D].x * 512; U[d][0] = ((const u32x4*)(Ub4 + ro))[0]; U[d][1] = ((const u32x4*)(Ub4 + ro))[1]; V[d][0] = ((const u32x4*)(Vb4 + ro))[0]; V[d][1] = ((const u32x4*)(Vb4 + ro))[1]; }
                    int ia = 0, ib = 0;
                    ia = __builtin_amdgcn_sdot8((int)u0.x, hq[0], ia, false); ib = __builtin_amdgcn_sdot8((int)u0.y, hq[1], ib, false); ia = __builtin_amdgcn_sdot8((int)u0.z, hq[2], ia, false); ib = __builtin_amdgcn_sdot8((int)u0.w, hq[3], ib, false);
                    ia = __builtin_amdgcn_sdot8((int)u1.x, hq[4], ia, false); ib = __builtin_amdgcn_sdot8((int)u1.y, hq[5], ib, false); ia = __builtin_amdgcn_sdot8((int)u1.z, hq[6], ia, false); ib = __builtin_amdgcn_sdot8((int)u1.w, hq[7], ib, false);
                    const float x = dpp_row_sum((float)(ia + ib)) * rsq;
                    const float e = fast_exp2(x * (-2.3022082f + -0.10294324f * x * x));
                    const _Float16 wh = (_Float16)(gate * x * __builtin_amdgcn_rcpf(1.f + e) * 16.f); const h16x2 w2 = (h16x2){wh, wh};
                    const unsigned vw[8] = {v0.x, v0.y, v0.z, v0.w, v1.x, v1.y, v1.z, v1.w};
#pragma unroll
                    for (int c8 = 0; c8 < 8; ++c8) {
                        acc[c8][0] = __builtin_elementwise_fma(w2, __builtin_bit_cast(h16x2, __builtin_amdgcn_cvt_scalef32_pk_f16_fp4(vw[c8], 1.0f, 0)), acc[c8][0]); acc[c8][1] = __builtin_elementwise_fma(w2, __builtin_bit_cast(h16x2, __builtin_amdgcn_cvt_scalef32_pk_f16_fp4(vw[c8], 1.0f, 1)), acc[c8][1]);
                        acc[c8][2] = __builtin_elementwise_fma(w2, __builtin_bit_cast(h16x2, __builtin_amdgcn_cvt_scalef32_pk_f16_fp4(vw[c8], 1.0f, 2)), acc[c8][2]); acc[c8][3] = __builtin_elementwise_fma(w2, __builtin_bit_cast(h16x2, __builtin_amdgcn_cvt_scalef32_pk_f16_fp4(vw[c8], 1.0f, 3)), acc[c8][3]); }
                }
            }
        }
        PLACE_PAD(8);
        { float ss = 0.f;
          const u32x4* ib = (const u32x4*)(x1b + (size_t)tok * 1024 + 64 * j); u32x4* ob = (u32x4*)(x2b + (size_t)tok * 1024 + 64 * j);
#pragma unroll
          for (int c8 = 0; c8 < 8; ++c8) { const u32x4 r = ib[c8];
              float xv[8];
              xv[0] = bf_lo(r.x); xv[1] = bf_hi(r.x); xv[2] = bf_lo(r.y); xv[3] = bf_hi(r.y); xv[4] = bf_lo(r.z); xv[5] = bf_hi(r.z); xv[6] = bf_lo(r.w); xv[7] = bf_hi(r.w);
#pragma unroll
              for (int c = 0; c < 4; ++c) { xv[2 * c] += (float)acc[c8][c].x * 0.0625f; xv[2 * c + 1] += (float)acc[c8][c].y * 0.0625f; ss += xv[2 * c] * xv[2 * c] + xv[2 * c + 1] * xv[2 * c + 1]; }
              ob[c8] = (u32x4){cvt_pk_bf16(xv[0], xv[1]), cvt_pk_bf16(xv[2], xv[3]), cvt_pk_bf16(xv[4], xv[5]), cvt_pk_bf16(xv[6], xv[7])}; }
          ss = dpp_row_sum(ss);
          if (j == 0) rowf[2 * TG + tok] = rsqrtf(ss * (1.f / 1024.f) + EPS); }
        asm volatile("s_waitcnt lgkmcnt(0)" ::: "memory");
    }
}

__device__ __forceinline__ void phase_final(const Params& P, int g) {
    const int lane = TIDX() & 63, gw = BIDX() * 8 + (TIDX() >> 6), NGW = gridDim.x * 8;
    float* xo = P.out + (size_t)g * TG * 1024; const bf16_t* x3b = (const bf16_t*)(P.ws + A_X3B); const float* rowf = (const float*)(P.ws + WS_ROW); const float* gf = P.in[IN_FG];
    f32x4 gv[2][2];
#pragma unroll
    for (int j = 0; j < 2; ++j) { gv[j][0] = ((const f32x4*)gf)[2 * (lane + 64 * j)]; gv[j][1] = ((const f32x4*)gf)[2 * (lane + 64 * j) + 1]; }
    for (int row0 = gw * 8; row0 < TG; row0 += NGW * 8) {
        u32x4 v[8][2]; float sq[8];
#pragma unroll
        for (int rr = 0; rr < 8; ++rr) { const u32x4* xr = (const u32x4*)(x3b + (size_t)(row0 + rr) * 1024) + lane; sq[rr] = (float)__float_as_uint(rowf[(3 + g) * TG + row0 + rr]) * RSQ_INV;
#pragma unroll
            for (int j = 0; j < 2; ++j) v[rr][j] = xr[64 * j]; }
#pragma unroll
        for (int rr = 0; rr < 8; ++rr) { const float sc = rsqrtf(sq[rr] * (1.f / 1024.f) + EPS); f32x4* xr = (f32x4*)(xo + (size_t)(row0 + rr) * 1024) + 2 * lane;
#pragma unroll
            for (int j = 0; j < 2; ++j) { const u32x4 w = v[rr][j];
                xr[128 * j] = (f32x4){bf_lo(w.x), bf_hi(w.x), bf_lo(w.y), bf_hi(w.y)} * sc * gv[j][0]; xr[128 * j + 1] = (f32x4){bf_lo(w.z), bf_hi(w.z), bf_lo(w.w), bf_hi(w.w)} * sc * gv[j][1]; } }
    }
}

#define XB_TMO      128
#define XB_XCNT(j)  (256  + 64 * (j))
#define XB_XSUB(j)  (1280 + 64 * (j))
#define XB_XGEN(j)  (2304 + 64 * (j))
#define XB_TOP      3328
#define XB_TOPGEN   3392
#define XCD_BAR_WORDS 3456
#define XB_SPIN_CAP (1u << 18)
__device__ __forceinline__ unsigned xb_ld(unsigned* p)              { return __hip_atomic_load(p, __ATOMIC_RELAXED, __HIP_MEMORY_SCOPE_AGENT); }
__device__ __forceinline__ unsigned xb_add(unsigned* p, unsigned v) { return __hip_atomic_fetch_add(p, v, __ATOMIC_RELAXED, __HIP_MEMORY_SCOPE_AGENT); }
__device__ __forceinline__ unsigned xb_xcc_id() { return (unsigned)__builtin_amdgcn_s_getreg((3 << 11) | 20) & 0xFu; }
#define XB_SPIN(cond, bar) do { unsigned _sp = 0; while (cond) { __builtin_amdgcn_s_sleep(1); \
    if ((++_sp & 255u) == 0u) { if (xb_ld(&(bar)[XB_TMO])) break; if (_sp > XB_SPIN_CAP) { atomicAdd(&(bar)[XB_TMO], 1u); break; } } } } while (0)
struct XcdBarrier { unsigned* bar; unsigned x; volatile LAS unsigned* st; };
__device__ __forceinline__ XcdBarrier xcd_barrier_post(unsigned* bar, volatile LAS unsigned* st) {
    XcdBarrier b; b.bar = bar; b.x = xb_xcc_id(); b.st = st;
    if (threadIdx.x == 0) (void)xb_add(&bar[XB_XCNT(b.x)], 1u);
    return b;
}
__device__ __forceinline__ void xcd_barrier_complete(unsigned* bar, unsigned x, unsigned& nloc, unsigned& nx) {
    const unsigned G = gridDim.x * gridDim.y * gridDim.z;
    unsigned sum, cnt, mine, sp = 0u;
    for (;;) {
        sum = 0u; cnt = 0u; mine = 0u;
#pragma unroll
        for (unsigned j = 0; j < 16; ++j) { const unsigned c = xb_ld(&bar[XB_XCNT(j)]); sum += c; cnt += (c > 0u) ? 1u : 0u; mine = (j == x) ? c : mine; }
        if (sum == G) break;
        __builtin_amdgcn_s_sleep(1);
        if ((++sp & 255u) == 0u) { if (xb_ld(&bar[XB_TMO])) break; if (sp > XB_SPIN_CAP) { atomicAdd(&bar[XB_TMO], 1u); break; } }
    }
    nloc = mine > 0u ? mine : 1u; nx = cnt > 0u ? cnt : 1u;
}
__device__ __forceinline__ void xcd_barrier(const XcdBarrier& b) {
    asm volatile("s_waitcnt vmcnt(0)" ::: "memory");
    __syncthreads();
    if (threadIdx.x == 0) {
        unsigned* bar = b.bar;
        __builtin_amdgcn_s_waitcnt(0);
        unsigned nloc = b.st[0], nx = b.st[1];
        if (nloc == 0u) { xcd_barrier_complete(bar, b.x, nloc, nx); b.st[0] = nloc; b.st[1] = nx; }
        const unsigned old = xb_add(&bar[XB_XSUB(b.x)], 1u);
        const unsigned gen = old / nloc;
        if (old + 1u == (gen + 1u) * nloc) {
            __builtin_amdgcn_fence(__ATOMIC_RELEASE, "agent");
            asm volatile("s_waitcnt vmcnt(0)" ::: "memory");
            const unsigned og = xb_add(&bar[XB_TOP], 1u);
            const unsigned tg = og / nx;
            if (og + 1u == (tg + 1u) * nx) xb_add(&bar[XB_TOPGEN], 1u);
            else XB_SPIN(xb_ld(&bar[XB_TOPGEN]) == tg, bar);
            __builtin_amdgcn_fence(__ATOMIC_ACQUIRE, "agent");
            xb_add(&bar[XB_XGEN(b.x)], 1u);
            asm volatile("s_waitcnt vmcnt(0)" ::: "memory");
        } else {
            XB_SPIN(xb_ld(&bar[XB_XGEN(b.x)]) == gen, bar);
            __builtin_amdgcn_fence(__ATOMIC_ACQUIRE, "agent");
            asm volatile("s_waitcnt vmcnt(0)" ::: "memory");
        }
    }
    __syncthreads();
}

__global__ void __launch_bounds__(512, 2) mk_fwd(Params P) {
    extern __shared__ __attribute__((aligned(16))) unsigned char smem[];
    LAS unsigned char* lds = (LAS unsigned char*)smem;
    cg::grid_group grid = cg::this_grid();
    const int lo = P.ph_lo, hi = P.ph_hi;
    asm volatile("s_nop 0\n\ts_nop 0\n\ts_nop 0\n\ts_nop 0");
    if (threadIdx.x < 64) ((LAS unsigned*)(lds + LDSCTL_OFF))[threadIdx.x] = 0u;
    __syncthreads();
    XcdBarrier xbar = xcd_barrier_post((unsigned*)(P.ws + WS_CTL), (volatile LAS unsigned*)(lds + LDSCTL_OFF));
#define PH_IN(k) (lo <= (k) && (k) < hi)
#define PH_END(k) do { if ((k) + 1 < hi) { if (hi > NPH) grid.sync(); else xcd_barrier(xbar); } } while (0)
#define PHASE(kk, idx, ...) if (PH_IN(idx)) { __VA_ARGS__; PH_END(idx); }
    PHASE(11, 0, { phase_prep(P, lds); phase_conv(P, 0); })
    for (int g = 0; g < 2; ++g) {
        const int pb = 10 * g;
        unsigned char* ws = P.ws;
        float* rowf = (float*)(ws + WS_ROW); float* xo = P.out + (size_t)g * TG * 1024;
        const int G = gridDim.x;
        PHASE(1, pb + 1, { pg8::Gemm gm{(const bf16_t*)(ws + A_XBK), (const bf16_t*)(ws + WS_WIN), 1024}; pg8::StaticOrder S; S.init(TG, NIN, G, BIDX());
            EpiInProj E{rowf, P.in[IN_AB], ws, (bf16_t*)xo}; pg8::gemm_phase<0>(lds, gm, S, E); })
        PHASE(2, pb + 2, phase_mix(P, g, lds))
        PHASE(3, pb + 3, phase_ogfix(P, g))
        PHASE(4, pb + 4, { pg8::Gemm gm{(const bf16_t*)(ws + A_OA), (const bf16_t*)(ws + WS_WUP), 512}; pg8::PairOrder S; S.init(TG, 1024, G, BIDX());
            EpiUp E{(const unsigned char*)xo, (bf16_t*)(ws + A_MERGED)}; pg8::gemm_phase<0>(lds, gm, S, E); })
        PHASE(5, pb + 5, { pg8::Gemm gm{(const bf16_t*)(ws + A_MERGED), (const bf16_t*)(ws + WS_WOUT), 1024}; pg8::StaticOrder S; S.init(TG, 1024, G, BIDX());
            EpiOut E{(const bf16_t*)(ws + A_XBK), (bf16_t*)(ws + A_X1B), (unsigned*)(rowf + TG)}; pg8::gemm_phase<0>(lds, gm, S, E); })
        PHASE(6, pb + 6, {
            { pg8::Gemm gm{(const bf16_t*)(ws + A_PB), (const bf16_t*)(ws + WS_WPLE), 256}; pg8::StaticOrder S; S.init(TG, 1024, G, BIDX());
              EpiPe E{(bf16_t*)(ws + A_PE)}; pg8::gemm_phase<0>(lds, gm, S, E); }
            { pg8::Gemm gm{(const bf16_t*)(ws + A_X1B), (const bf16_t*)(ws + WS_WQ), 1024}; pg8::StaticOrder S; S.init(TG, 2048, G, BIDX());
              EpiQ E{(const unsigned*)(rowf + TG), (bf16_t*)(ws + A_Q)}; pg8::gemm_phase<0>(lds, gm, S, E); } })
        PHASE(7, pb + 7, phase_topk(P, g, lds))
        PHASE(8, pb + 8, phase_gather(P, g, lds))
        PHASE(9, pb + 9, { pg8::Gemm gm{(const bf16_t*)(ws + A_X2B), (const bf16_t*)(ws + WS_WGATE), 1024}; pg8::StaticOrder S; S.init(TG, 1024, G, BIDX());
            EpiGate E{rowf + 2 * TG, (const bf16_t*)(ws + A_PE), (const bf16_t*)(ws + A_X2B), (bf16_t*)(ws + A_X3B), (unsigned*)(rowf + (3 + g) * TG)}; pg8::gemm_phase<0>(lds, gm, S, E); })
        PHASE(10, pb + 10, { phase_final(P, g); if (g == 0) phase_conv(P, 1); })
    }
#undef PHASE
#undef PH_IN
#undef PH_END
}

extern "C" void kernel_launch(void* const* d_in, const int* in_sizes, int n_in, void* d_out, int out_size, void* d_ws, size_t ws_size, hipStream_t stream) {
    static int grid = 0;
    if (grid == 0) {
        if (n_in != 24 || ws_size < WS_END) { fprintf(stderr, "kernel_launch: need 24 inputs and >= %zu bytes of workspace (got %d, %zu)\n", (size_t)WS_END, n_in, ws_size); grid = -1; return; }
        if (hipFuncSetAttribute((const void*)mk_fwd, hipFuncAttributeMaxDynamicSharedMemorySize, LDS_BYTES) != hipSuccess) { fprintf(stderr, "kernel_launch: hipFuncSetAttribute failed\n"); grid = -1; return; }
        int dev = 0, cus = 0, per_cu = 0; (void)hipGetDevice(&dev); (void)hipDeviceGetAttribute(&cus, hipDeviceAttributeMultiprocessorCount, dev);
        if (hipOccupancyMaxActiveBlocksPerMultiprocessor(&per_cu, (const void*)mk_fwd, 512, LDS_BYTES) != hipSuccess || per_cu < 1) per_cu = 1;
        (void)hipGetLastError();
        grid = (cus > 0 ? cus : 256) * (per_cu > 1 ? 1 : per_cu);
    }
    if (grid < 0) return;
    Params P{};
    for (int i = 0; i < 24; ++i) P.in[i] = (const float*)d_in[i];
    P.out = (float*)d_out; P.ws = (unsigned char*)d_ws;
    P.ph_lo = 0; P.ph_hi = NPH;
    (void)hipMemsetAsync((unsigned char*)d_ws + WS_CTL, 0, 32768, stream);
    { void* args[] = {&P};
      hipError_t e = hipLaunchCooperativeKernel((const void*)mk_fwd, dim3(grid), dim3(512), args, LDS_BYTES, stream);
      if (e != hipSuccess) fprintf(stderr, "cooperative launch failed: %s (grid %d)\n", hipGetErrorString(e), grid); }
}
```

```cpp
#include <hip/hip_runtime.h>
#include <hip/hip_cooperative_groups.h>
#include <stdint.h>
#include <stdio.h>
namespace cg = cooperative_groups;

#define LAS __attribute__((address_space(3)))
#define PLACE_PAD(n) asm volatile(".rept %0\n\ts_nop 0\n\t.endr" :: "n"(n))
template <int KK> struct PhasePad { static constexpr int N = 0; };
template <> struct PhasePad<1> { static constexpr int N = 12; };
template <> struct PhasePad<2> { static constexpr int N = 8; };
template <> struct PhasePad<4> { static constexpr int N = 4; };
template <> struct PhasePad<8> { static constexpr int N = 6; };
typedef unsigned short bf16_t;
typedef short bf16x8 __attribute__((ext_vector_type(8)));
typedef short s16x4 __attribute__((ext_vector_type(4)));
typedef float f32x4 __attribute__((ext_vector_type(4)));
typedef float f32x16 __attribute__((ext_vector_type(16)));
typedef int i32x8 __attribute__((ext_vector_type(8)));
typedef unsigned u32x4 __attribute__((ext_vector_type(4)));
typedef unsigned u32x2 __attribute__((ext_vector_type(2)));

constexpr int DM = 1024, TG = 32768, NIN = 5632;
constexpr float EPS = 1e-6f;
constexpr float LOG2E = 1.4426950408889634f;
constexpr float QSCALE = 0.125f * LOG2E;
constexpr int NPH = 21;
constexpr int LDS_BYTES = 147456;
constexpr int LDSCTL_OFF = LDS_BYTES - 256;

constexpr size_t MB = (size_t)1 << 20;
constexpr size_t WS_CTL = 0;
constexpr size_t WS_SMALL = 65536;
constexpr size_t WS_ROW = 131072;
constexpr float RSQ_FIX = 4096.f, RSQ_INV = 1.f / 4096.f;
constexpr size_t WS_WIN = 1 * MB;
constexpr size_t WS_WUP = WS_WIN + 11 * MB;
constexpr size_t WS_WOUT = WS_WUP + 2 * MB;
constexpr size_t WS_WQ = WS_WOUT + 2 * MB;
constexpr size_t WS_WGATE = WS_WQ + 4 * MB;
constexpr size_t WS_WPLE = WS_WGATE + 2 * MB;
constexpr size_t WS_SK = WS_WPLE + 1 * MB;
constexpr size_t WS_UB = WS_SK + 1 * MB;
constexpr size_t WS_VB = WS_UB + 8 * MB;
constexpr size_t WS_ACT = WS_VB + 8 * MB;
constexpr size_t A_XB = WS_ACT;
constexpr size_t A_OA = A_XB;
constexpr size_t A_OG = A_XB + 32 * MB;
constexpr size_t A_PE = A_XB;
constexpr size_t A_QA = A_XB + 64 * MB;
constexpr size_t A_KA = A_QA + 32 * MB;
constexpr size_t A_VA = A_KA + 32 * MB;
constexpr size_t A_QG = A_VA + 32 * MB;
constexpr size_t A_KG = A_QG + 16 * MB;
constexpr size_t A_VG = A_KG + 16 * MB;
constexpr size_t A_LA = A_VG + 32 * MB;
constexpr size_t A_RGS = A_LA + 32 * MB;
constexpr size_t A_OF = A_RGS + 32 * MB;
constexpr size_t A_OB = A_OF + 32 * MB;
constexpr size_t A_PB = A_OB + 32 * MB;
constexpr size_t A_XBK = A_PB + 16 * MB;
constexpr size_t WS_END = A_XBK + 64 * MB;
constexpr size_t A_MERGED = A_QA;
constexpr size_t A_X2B = A_QA;
constexpr size_t A_X1B = A_VA;
constexpr size_t A_X3B = A_VA;
constexpr size_t A_Q = A_VG;
constexpr size_t A_IDX = A_OB;
constexpr size_t A_GW = A_OB + 8 * MB;
static_assert(A_RGS + 32 * MB == A_OF && A_Q + 128 * MB == A_OB, "layout");

struct Params {
    const float* in[24];
    float* out;
    unsigned char* ws;
    int ph_lo, ph_hi;
};

typedef __bf16 bf16x2_t __attribute__((ext_vector_type(2)));
typedef float f32x2 __attribute__((ext_vector_type(2)));
__device__ __forceinline__ unsigned cvt_pk_bf16(float lo, float hi) { const f32x2 v = {lo, hi}; const bf16x2_t b = __builtin_convertvector(v, bf16x2_t); return __builtin_bit_cast(unsigned, b); }
__device__ __forceinline__ bf16_t f2bf(float f) { return (bf16_t)(cvt_pk_bf16(f, 0.f) & 0xffffu); }
__device__ __forceinline__ float bf_lo(unsigned w) { return __uint_as_float(w << 16); }
__device__ __forceinline__ float bf_hi(unsigned w) { return __uint_as_float(w & 0xffff0000u); }
__device__ __forceinline__ float bf2f(bf16_t b) { return __uint_as_float((unsigned)b << 16); }
__device__ __forceinline__ int TIDX() { int t = threadIdx.x; asm volatile("" : "+v"(t)); return t; }
__device__ __forceinline__ int BIDX() { int b = blockIdx.x; asm volatile("" : "+v"(b)); return __builtin_amdgcn_readfirstlane(b); }
__device__ __forceinline__ float wave_sum(float v) {
#pragma unroll
    for (int o = 1; o < 64; o <<= 1) v += __shfl_xor(v, o);
    return v;
}
__device__ __forceinline__ float fast_sigmoid(float x) { return __builtin_amdgcn_rcpf(1.f + __expf(-x)); }
__device__ __forceinline__ float fast_exp2(float x) { return __builtin_amdgcn_exp2f(x); }
__device__ __forceinline__ int crow(int r, int hi) { return (r & 3) + 8 * (r >> 2) + 4 * hi; }
#define MFMA32(a, b, c) __builtin_amdgcn_mfma_f32_32x32x16_bf16(a, b, c, 0, 0, 0)
#define MFMA_F8(a, b, c) __builtin_amdgcn_mfma_scale_f32_32x32x64_f8f6f4(a, b, c, 0, 0, 0, 0x7F7F7F7F, 0, 0x7B7B7B7B)
#define MFMA16(a, b, c) __builtin_amdgcn_mfma_f32_16x16x32_bf16(a, b, c, 0, 0, 0)
typedef short v4i16_t __attribute__((ext_vector_type(4)));
__device__ __forceinline__ s16x4 lds_tr(LAS const unsigned char* p) { return __builtin_bit_cast(s16x4, __builtin_amdgcn_ds_read_tr16_b64_v4i16((LAS v4i16_t*)p)); }

namespace pg8 {
constexpr int BM = 256, BK = 64, HALF = 128, HTB = HALF * BK * 2, STAGE_BYTES = 8 * HTB, NXCD = 8, WGM = 8;
__host__ __device__ __forceinline__ int lds_byte(int r, int c) { const int st = (r >> 4) * 2 + (c >> 5), rr = r & 15, cc = c & 31, ob = rr * 64 + cc * 2; return st * 1024 + (ob ^ (((ob >> 9) & 1) << 5)); }
__host__ __device__ __forceinline__ void stage_rc(int b, int& R, int& C) { const int st = b / 1024, sb = b % 1024, swz = sb ^ (((sb >> 9) & 1) << 5); R = (st >> 1) * 16 + swz / 64; C = (st & 1) * 32 + (swz % 64) / 2; }
__host__ __device__ __forceinline__ int perm32(int rho) { const int n = rho >> 4, i = rho & 15; return 8 * (i >> 2) + 4 * n + (i & 3); }
struct Unit { int pm, pn; };
struct Gemm { const bf16_t* A; const bf16_t* Bt; int K; };
__device__ __forceinline__ void tile_of(int L, int nM, int nN, int& pm, int& pn) {
    const int nwg = nM * nN; int wgid = L;
    { const int q = nwg / NXCD, r = nwg % NXCD, xcd = wgid % NXCD, off = wgid / NXCD; wgid = (xcd < r ? xcd * (q + 1) : r * (q + 1) + (xcd - r) * q) + off; }
    const int nig = WGM * nN, gid = wgid / nig, fm = gid * WGM, gsz = (nM - fm) < WGM ? (nM - fm) : WGM;
    pm = fm + ((wgid % nig) % gsz); pn = (wgid % nig) / gsz;
}
struct StaticOrder {
    int nM, nN, G, c;
    __device__ void init(int M, int N, int G_, int c_) { nM = M / BM; nN = N / BM; G = G_; c = c_; }
    __device__ bool next(int i, Unit& u) const { const long L = (long)i * G + c; if (L >= (long)nM * nN) return false; tile_of((int)L, nM, nN, u.pm, u.pn); return true; }
};
struct PairOrder {
    int nM, nN, G, c;
    __device__ void init(int M, int N, int G_, int c_) { nM = M / BM; nN = N / BM; G = G_; c = c_; }
    __device__ bool next(int i, Unit& u) const { const long L = (long)(i >> 1) * G + c; if (L >= (long)nM * nN) return false; tile_of((int)L, nM, nN, u.pm, u.pn);
        if (i & 1) { u.pm += nM; u.pn += nN; } return true; }
};

template <class Epi, class Sched>
__device__ __forceinline__ void gemm_phase(LAS unsigned char* lds, const Gemm g, const Sched& S, const Epi& E) {
    const int tid = TIDX(), wid = __builtin_amdgcn_readfirstlane(tid >> 6), lane = tid & 63, wr = wid >> 2, wc = wid & 3, fr = lane & 15, fq = lane >> 4;
    const int K = g.K, nt = K / BK;
    unsigned voffA[2], voffB[2];
#pragma unroll
    for (int i = 0; i < 2; ++i) { int R, C; stage_rc(tid * 16 + i * 8192, R, C); const int Rb = Epi::PERM ? ((R & ~31) + perm32(R & 31)) : R;
        voffA[i] = (unsigned)(R * K + C) * 2u; voffB[i] = (unsigned)(Rb * K + C) * 2u; }
    const size_t kstep = (size_t)(BK * 2);
    const size_t hstep = (size_t)HALF * K * 2;
    const size_t tstep = 2 * hstep;
    const unsigned ldsw = (unsigned)wid * 1024u;
    const int aoff = lds_byte(wr * 64 + fr, fq * 8), boff = lds_byte(wc * 32 + fr, fq * 8);
#define PG8_SA(b, h) (((b) * 2 + (h)) * HTB)
#define PG8_SB(b, h) ((4 + (b) * 2 + (h)) * HTB)
#define PG8_STAGE(bufoff, gbase, voff) do { _Pragma("unroll") for (int _i = 0; _i < 2; ++_i) \
        __builtin_amdgcn_global_load_lds((const unsigned*)((const char*)(gbase) + (voff)[_i]), (LAS unsigned*)(lds + (bufoff) + ldsw + _i * 8192), 16, 0, 0); } while (0)
#define PG8_LDA(dst, b, h) do { _Pragma("unroll") for (int m = 0; m < 4; ++m) _Pragma("unroll") for (int k = 0; k < 2; ++k) dst[m][k] = *(const LAS bf16x8*)(lds + PG8_SA(b, h) + aoff + m * 2048 + k * 1024); } while (0)
#define PG8_LDB(dst, b, h) do { _Pragma("unroll") for (int n = 0; n < 2; ++n) _Pragma("unroll") for (int k = 0; k < 2; ++k) dst[n][k] = *(const LAS bf16x8*)(lds + PG8_SB(b, h) + boff + n * 2048 + k * 1024); } while (0)
#define PG8_MMA(ai, bj, At, Bt) do { __builtin_amdgcn_s_setprio(1); _Pragma("unroll") for (int m = 0; m < 4; ++m) _Pragma("unroll") for (int n = 0; n < 2; ++n) _Pragma("unroll") for (int k = 0; k < 2; ++k) \
        acc[ai][bj][m][n] = __builtin_amdgcn_mfma_f32_16x16x32_bf16(Bt[n][k], At[m][k], acc[ai][bj][m][n], 0, 0, 0); __builtin_amdgcn_s_setprio(0); } while (0)
#define PG8_WAIT_V(n) asm volatile("s_waitcnt vmcnt(" #n ")" ::: "memory")
#define PG8_WAIT_L(n) asm volatile("s_waitcnt lgkmcnt(" #n ")" ::: "memory")
#define PG8_BAR __builtin_amdgcn_s_barrier()
#define PG8_SCHED __builtin_amdgcn_sched_barrier(0)
    Unit cur, nxt; int ui = 0;
    if (!S.next(0, cur)) return;
    f32x4 acc[2][2][4][2];
#pragma unroll
    for (int a = 0; a < 2; ++a)
#pragma unroll
        for (int b = 0; b < 2; ++b)
#pragma unroll
            for (int m = 0; m < 4; ++m)
#pragma unroll
                for (int n = 0; n < 2; ++n) acc[a][b][m][n] = (f32x4){0.f, 0.f, 0.f, 0.f};
    bf16x8 At[4][2], B0[2][2], B1[2][2];
    const char* cA = (const char*)g.A + (size_t)cur.pm * tstep; const char* cB = (const char*)g.Bt + (size_t)cur.pn * tstep;
    PG8_STAGE(PG8_SB(0, 0), cB, voffB); PG8_STAGE(PG8_SA(0, 0), cA, voffA); PG8_STAGE(PG8_SB(0, 1), cB + hstep, voffB); PG8_STAGE(PG8_SA(0, 1), cA + hstep, voffA);
    if (wr == 1) PG8_BAR;
    PG8_WAIT_V(4); PG8_BAR;
    PG8_STAGE(PG8_SB(1, 0), cB + kstep, voffB); PG8_STAGE(PG8_SA(1, 0), cA + kstep, voffA); PG8_STAGE(PG8_SB(1, 1), cB + hstep + kstep, voffB);
    PG8_WAIT_V(6); PG8_BAR;
    for (;;) {
        const bool has_next = S.next(ui + 1, nxt);
        const char* nA = has_next ? (const char*)g.A + (size_t)nxt.pm * tstep : cA; const char* nB = has_next ? (const char*)g.Bt + (size_t)nxt.pn * tstep : cB;
        for (int t = 0; t < nt; t += 2) {
            const bool last = (t == nt - 2);
            const char* a1 = cA + (size_t)(t + 1) * kstep;
            const char* a2 = last ? nA : cA + (size_t)(t + 2) * kstep; const char* b2 = last ? nB : cB + (size_t)(t + 2) * kstep;
            const char* a3 = a2 + kstep; const char* b3 = b2 + kstep;
            PG8_LDB(B0, 0, 0); PG8_SCHED; PG8_LDA(At, 0, 0); PG8_STAGE(PG8_SA(1, 1), a1 + hstep, voffA);
            PG8_WAIT_L(8); PG8_BAR; PG8_WAIT_L(0); PG8_MMA(0, 0, At, B0); PG8_BAR; PG8_SCHED;
            PG8_LDB(B1, 0, 1); PG8_STAGE(PG8_SB(0, 0), b2, voffB);
            PG8_BAR; PG8_WAIT_L(0); PG8_MMA(0, 1, At, B1); PG8_BAR;
            PG8_LDA(At, 0, 1); PG8_STAGE(PG8_SA(0, 0), a2, voffA);
            PG8_BAR; PG8_WAIT_L(0); PG8_MMA(1, 0, At, B0); PG8_BAR; PG8_SCHED;
            PG8_STAGE(PG8_SB(0, 1), b2 + hstep, voffB);
            PG8_WAIT_V(6); PG8_BAR; PG8_MMA(1, 1, At, B1); PG8_BAR;
            PG8_LDB(B0, 1, 0); PG8_SCHED; PG8_LDA(At, 1, 0); PG8_STAGE(PG8_SA(0, 1), a2 + hstep, voffA);
            PG8_WAIT_L(8); PG8_BAR; PG8_WAIT_L(0); PG8_MMA(0, 0, At, B0); PG8_BAR; PG8_SCHED;
            PG8_LDB(B1, 1, 1); PG8_STAGE(PG8_SB(1, 0), b3, voffB);
            PG8_BAR; PG8_WAIT_L(0); PG8_MMA(0, 1, At, B1); PG8_BAR;
            PG8_LDA(At, 1, 1); PG8_STAGE(PG8_SA(1, 0), a3, voffA);
            PG8_BAR; PG8_WAIT_L(0); PG8_MMA(1, 0, At, B0); PG8_BAR; PG8_SCHED;
            PG8_STAGE(PG8_SB(1, 1), b3 + hstep, voffB);
            PG8_WAIT_V(6); PG8_BAR; PG8_MMA(1, 1, At, B1); PG8_BAR;
        }
        E(acc, cur, wr, wc, fr, fq);
        if (!has_next) break;
#pragma unroll
        for (int a = 0; a < 2; ++a)
#pragma unroll
            for (int b = 0; b < 2; ++b)
#pragma unroll
                for (int m = 0; m < 4; ++m)
#pragma unroll
                    for (int n = 0; n < 2; ++n) acc[a][b][m][n] = (f32x4){0.f, 0.f, 0.f, 0.f};
        cur = nxt; cA = nA; cB = nB; ++ui;
    }
    PG8_WAIT_V(0);
    if (wr == 0) PG8_BAR;
    PG8_BAR;
#undef PG8_SA
#undef PG8_SB
#undef PG8_STAGE
#undef PG8_LDA
#undef PG8_LDB
#undef PG8_MMA
#undef PG8_WAIT_V
#undef PG8_WAIT_L
#undef PG8_BAR
#undef PG8_SCHED
}
}
using pg8::Unit;


enum { IN_XP = 0, IN_XS, IN_PP, IN_PS, IN_RELB, IN_N1G, IN_WIN, IN_LQK, IN_DAG, IN_AW, IN_AB, IN_GLAG, IN_WUPA, IN_WUPB, IN_WOUT, IN_N2G, IN_WQ, IN_SK, IN_PU, IN_PV, IN_N3G, IN_PLEW, IN_PLEG, IN_FG };
constexpr int SM_LAM = 2048;
constexpr float U_SCALE = 96.f, V_SCALE = 24.f;

struct EpiInProj {
    static constexpr bool PERM = true;
    const float* rs; const float* zb; unsigned char* ws; bf16_t* gl;
    __device__ __forceinline__ void operator()(const f32x4 (&acc)[2][2][4][2], const Unit& u, int wr, int wc, int fr, int fq) const {
        const int pn = u.pn;
        bf16_t* base; int ld, colt, mode = 0; float sc = 1.f;
        if (pn < 2)       { base = (bf16_t*)(ws + A_QA); ld = 512; colt = pn * 256; sc = QSCALE * 16.f; mode = 4; }
        else if (pn < 4)  { base = (bf16_t*)(ws + A_KA); ld = 512; colt = (pn - 2) * 256; mode = 4; }
        else if (pn < 6)  { base = (bf16_t*)(ws + A_VA); ld = 512; colt = (pn - 4) * 256; }
        else if (pn == 6) { base = (bf16_t*)(ws + A_QG); ld = 256; colt = 0; sc = 0.125f; }
        else if (pn == 7) { base = (bf16_t*)(ws + A_KG); ld = 256; colt = 0; }
        else if (pn < 10) { base = (bf16_t*)(ws + A_VG); ld = 512; colt = (pn - 8) * 256; }
        else if (pn < 12) { base = (bf16_t*)(ws + A_RGS); ld = 512; colt = (pn - 10) * 256; mode = 1; }
        else if (pn < 14) { base = (bf16_t*)(ws + A_LA); ld = 512; colt = (pn - 12) * 256; mode = 2; }
        else              { base = gl; ld = 2048; colt = (pn - 14) * 256; mode = 3; }
        const bool blk = (pn == 6) | (pn == 7) | (pn == 12) | (pn == 13);
        const int row0 = u.pm * 256 + wr * 64 + fr, col0 = colt + wc * 32 + 8 * fq;
        float zbv[2][8];
#pragma unroll
        for (int bj = 0; bj < 2; ++bj)
#pragma unroll
            for (int j = 0; j < 8; ++j) zbv[bj][j] = (mode == 2) ? zb[col0 + bj * 128 + j] : 0.f;
        float rsv[2][4];
#pragma unroll
        for (int ai = 0; ai < 2; ++ai)
#pragma unroll
            for (int m = 0; m < 4; ++m) rsv[ai][m] = rs[row0 + ai * 128 + m * 16];
        if (mode >= 3) {
            unsigned char* bbase = (mode == 3) ? (unsigned char*)gl : (unsigned char*)base; const int ldb = (mode == 3) ? 2048 : 512; const int odd = fq & 1;
#pragma unroll
            for (int ai = 0; ai < 2; ++ai)
#pragma unroll
                for (int mp = 0; mp < 4; mp += 2)
#pragma unroll
                    for (int bj = 0; bj < 2; ++bj) {
                        unsigned wv[2][2];
#pragma unroll
                        for (int k = 0; k < 2; ++k) { const int m = mp + k; const float r = rsv[ai][m] * sc; float v[8];
#pragma unroll
                            for (int j = 0; j < 4; ++j) { v[j] = acc[ai][bj][m][0][j] * r; v[4 + j] = acc[ai][bj][m][1][j] * r; }
                            unsigned w0 = 0u, w1 = 0u;
                            if (mode == 4) {
#pragma unroll
                                for (int j = 0; j < 8; ++j) v[j] = __builtin_amdgcn_fmed3f(v[j], -448.f, 448.f);
                                w0 = __builtin_amdgcn_cvt_pk_fp8_f32(v[0], v[1], w0, false); w0 = __builtin_amdgcn_cvt_pk_fp8_f32(v[2], v[3], w0, true);
                                w1 = __builtin_amdgcn_cvt_pk_fp8_f32(v[4], v[5], w1, false); w1 = __builtin_amdgcn_cvt_pk_fp8_f32(v[6], v[7], w1, true);
                            } else {
#pragma unroll
                                for (int j = 0; j < 4; ++j) { w0 = __builtin_amdgcn_cvt_pk_u8_f32(255.f * fast_sigmoid(v[j]), j, w0); w1 = __builtin_amdgcn_cvt_pk_u8_f32(255.f * fast_sigmoid(v[4 + j]), j, w1); }
                            }
                            wv[k][0] = w0; wv[k][1] = w1; }
                        const auto s0 = __builtin_amdgcn_permlane16_swap(wv[0][0], wv[1][0], false, false), s1 = __builtin_amdgcn_permlane16_swap(wv[0][1], wv[1][1], false, false);
                        const int row = row0 + ai * 128 + (mp + odd) * 16;
                        *(u32x4*)(bbase + (size_t)row * ldb + col0 - 8 * odd + bj * 128) = (u32x4){s0[0], s1[0], s0[1], s1[1]};
                    }
            return;
        }
#pragma unroll
        for (int ai = 0; ai < 2; ++ai)
#pragma unroll
            for (int m = 0; m < 4; ++m) {
                const int row = row0 + ai * 128 + m * 16; const float r = rsv[ai][m] * sc;
                bf16_t* rowp = blk ? base + (size_t)(row >> 6) * (64 * ld) + (row & 63) * 8 + (col0 >> 3) * 512 : base + (size_t)row * ld + col0;
#pragma unroll
                for (int bj = 0; bj < 2; ++bj) {
                    float v[8];
#pragma unroll
                    for (int j = 0; j < 4; ++j) { v[j] = acc[ai][bj][m][0][j] * r; v[4 + j] = acc[ai][bj][m][1][j] * r; }
                    if (mode == 1) {
#pragma unroll
                        for (int j = 0; j < 8; ++j) v[j] = v[j] * fast_sigmoid(v[j]);
                    } else if (mode == 2) {
#pragma unroll
                        for (int j = 0; j < 8; ++j) { const float z = v[j] + zbv[bj][j]; v[j] = (fminf(z, 0.f) - __logf(1.f + __expf(-fabsf(z)))) * 0.0625f; }
                    }
                    u32x4 w; w.x = cvt_pk_bf16(v[0], v[1]); w.y = cvt_pk_bf16(v[2], v[3]); w.z = cvt_pk_bf16(v[4], v[5]); w.w = cvt_pk_bf16(v[6], v[7]);
                    *(u32x4*)(rowp + bj * (blk ? 8192 : 128)) = w;
                }
            }
    }
};
struct EpiUp {
    static constexpr bool PERM = true;
    const unsigned char* gl; bf16_t* merged;
    static __device__ __forceinline__ float gb(unsigned w, int j) { return (float)((w >> (8 * j)) & 0xffu) * (1.f / 255.f); }
    __device__ __forceinline__ void operator()(const f32x4 (&acc)[2][2][4][2], const Unit& u, int wr, int wc, int fr, int fq) const {
        const int pass = u.pm >= (TG / 256) ? 1 : 0; const int pm = u.pm - pass * (TG / 256), pn = u.pn - pass * 4;
        const int row0 = pm * 256 + wr * 64 + fr, col0 = pn * 256 + wc * 32 + 8 * fq;
        if (!pass) {
#pragma unroll
            for (int ai = 0; ai < 2; ++ai) { u32x2 gt[4][2];
#pragma unroll
                for (int m = 0; m < 4; ++m)
#pragma unroll
                    for (int bj = 0; bj < 2; ++bj) gt[m][bj] = *(const u32x2*)(gl + (size_t)(row0 + ai * 128 + m * 16) * 2048 + col0 + bj * 128);
#pragma unroll
                for (int m = 0; m < 4; ++m)
#pragma unroll
                    for (int bj = 0; bj < 2; ++bj) { const size_t row = row0 + ai * 128 + m * 16; const int c = col0 + bj * 128; const u32x2 g = gt[m][bj]; float v[8];
#pragma unroll
                        for (int j = 0; j < 4; ++j) { v[j] = acc[ai][bj][m][0][j] * gb(g.x, j); v[4 + j] = acc[ai][bj][m][1][j] * gb(g.y, j); }
                        *(u32x4*)(merged + row * 1024 + c) = (u32x4){cvt_pk_bf16(v[0], v[1]), cvt_pk_bf16(v[2], v[3]), cvt_pk_bf16(v[4], v[5]), cvt_pk_bf16(v[6], v[7])}; } }
        } else {
#pragma unroll
            for (int am = 0; am < 4; ++am) { const int ai = am >> 1, mb = (am & 1) * 2;
                u32x2 gt[4][2]; u32x4 ov[4][2];
#pragma unroll
                for (int m = mb; m < mb + 2; ++m)
#pragma unroll
                    for (int bj = 0; bj < 2; ++bj) { const size_t row = row0 + ai * 128 + m * 16; const int c = col0 + bj * 128;
                        gt[m][bj] = *(const u32x2*)(gl + row * 2048 + 1024 + c); ov[m][bj] = *(const u32x4*)(merged + row * 1024 + c); }
#pragma unroll
                for (int m = mb; m < mb + 2; ++m)
#pragma unroll
                    for (int bj = 0; bj < 2; ++bj) { const size_t row = row0 + ai * 128 + m * 16; const int c = col0 + bj * 128;
                        const u32x2 g = gt[m][bj]; const u32x4 o = ov[m][bj]; float v[8];
                        const float of[8] = {bf_lo(o.x), bf_hi(o.x), bf_lo(o.y), bf_hi(o.y), bf_lo(o.z), bf_hi(o.z), bf_lo(o.w), bf_hi(o.w)};
#pragma unroll
                        for (int j = 0; j < 4; ++j) { v[j] = acc[ai][bj][m][0][j] * gb(g.x, j) + of[j]; v[4 + j] = acc[ai][bj][m][1][j] * gb(g.y, j) + of[4 + j]; }
                        *(u32x4*)(merged + row * 1024 + c) = (u32x4){cvt_pk_bf16(v[0], v[1]), cvt_pk_bf16(v[2], v[3]), cvt_pk_bf16(v[4], v[5]), cvt_pk_bf16(v[6], v[7])}; }
            }
        }
    }
};
struct EpiOut {
    static constexpr bool PERM = true;
    const bf16_t* xb; bf16_t* x1b; unsigned* rowsq;
    __device__ __forceinline__ void operator()(const f32x4 (&acc)[2][2][4][2], const Unit& u, int wr, int wc, int fr, int fq) const {
        const int row0 = u.pm * 256 + wr * 64 + fr, col0 = u.pn * 256 + wc * 32 + 8 * fq;
#pragma unroll
        for (int ai = 0; ai < 2; ++ai) {
            u32x4 xw[4][2];
#pragma unroll
            for (int m = 0; m < 4; ++m)
#pragma unroll
                for (int bj = 0; bj < 2; ++bj) xw[m][bj] = *(const u32x4*)(xb + (size_t)(row0 + ai * 128 + m * 16) * 1024 + col0 + bj * 128);
#pragma unroll
            for (int m = 0; m < 4; ++m) {
                const int row = row0 + ai * 128 + m * 16; float ss = 0.f;
#pragma unroll
                for (int bj = 0; bj < 2; ++bj) {
                    const size_t off = (size_t)row * 1024 + col0 + bj * 128; const u32x4 w = xw[m][bj];
                    const f32x4 o0 = (f32x4){bf_lo(w.x), bf_hi(w.x), bf_lo(w.y), bf_hi(w.y)} + acc[ai][bj][m][0], o1 = (f32x4){bf_lo(w.z), bf_hi(w.z), bf_lo(w.w), bf_hi(w.w)} + acc[ai][bj][m][1];
                    *(u32x4*)(x1b + off) = (u32x4){cvt_pk_bf16(o0[0], o0[1]), cvt_pk_bf16(o0[2], o0[3]), cvt_pk_bf16(o1[0], o1[1]), cvt_pk_bf16(o1[2], o1[3])};
                    ss += ((o0[0] * o0[0] + o0[1] * o0[1]) + (o0[2] * o0[2] + o0[3] * o0[3])) + ((o1[0] * o1[0] + o1[1] * o1[1]) + (o1[2] * o1[2] + o1[3] * o1[3]));
                }
                ss += __shfl_xor(ss, 16); ss += __shfl_xor(ss, 32);
                if (fq == 0) atomicAdd(rowsq + row, (unsigned)(ss * RSQ_FIX + 0.5f));
            }
        }
    }
};
struct EpiQ {
    static constexpr bool PERM = true;
    const unsigned* rowsq; bf16_t* q;
    __device__ __forceinline__ void operator()(const f32x4 (&acc)[2][2][4][2], const Unit& u, int wr, int wc, int fr, int fq) const {
        const int row0 = u.pm * 256 + wr * 64 + fr, col0 = u.pn * 256 + wc * 32 + 8 * fq;
        float rsv[2][4];
#pragma unroll
        for (int ai = 0; ai < 2; ++ai)
#pragma unroll
            for (int m = 0; m < 4; ++m) rsv[ai][m] = (float)rowsq[row0 + ai * 128 + m * 16] * RSQ_INV;
#pragma unroll
        for (int ai = 0; ai < 2; ++ai)
#pragma unroll
            for (int m = 0; m < 4; ++m) {
                const int row = row0 + ai * 128 + m * 16; const float r = rsqrtf(rsv[ai][m] * (1.f / 1024.f) + EPS);
#pragma unroll
                for (int bj = 0; bj < 2; ++bj) {
                    const f32x4 a = acc[ai][bj][m][0] * r, b = acc[ai][bj][m][1] * r;
                    u32x4 w; w.x = cvt_pk_bf16(a[0], a[1]); w.y = cvt_pk_bf16(a[2], a[3]); w.z = cvt_pk_bf16(b[0], b[1]); w.w = cvt_pk_bf16(b[2], b[3]);
                    *(u32x4*)(q + (size_t)row * 2048 + col0 + bj * 128) = w;
                }
            }
    }
};
struct EpiPe {
    static constexpr bool PERM = true;
    bf16_t* pe;
    __device__ __forceinline__ void operator()(const f32x4 (&acc)[2][2][4][2], const Unit& u, int wr, int wc, int fr, int fq) const {
        const int row0 = u.pm * 256 + wr * 64 + fr, col0 = u.pn * 256 + wc * 32 + 8 * fq;
#pragma unroll
        for (int ai = 0; ai < 2; ++ai)
#pragma unroll
            for (int m = 0; m < 4; ++m) {
                const int row = row0 + ai * 128 + m * 16;
#pragma unroll
                for (int bj = 0; bj < 2; ++bj) {
                    const f32x4 a = acc[ai][bj][m][0], b = acc[ai][bj][m][1];
                    u32x4 w; w.x = cvt_pk_bf16(a[0], a[1]); w.y = cvt_pk_bf16(a[2], a[3]); w.z = cvt_pk_bf16(b[0], b[1]); w.w = cvt_pk_bf16(b[2], b[3]);
                    *(u32x4*)(pe + (size_t)row * 1024 + col0 + bj * 128) = w;
                }
            }
    }
};
struct EpiGate {
    static constexpr bool PERM = true;
    const float* rs3; const bf16_t* pe; const bf16_t* x2b; bf16_t* x3b; unsigned* rowsq;
    __device__ __forceinline__ void operator()(const f32x4 (&acc)[2][2][4][2], const Unit& u, int wr, int wc, int fr, int fq) const {
        const int row0 = u.pm * 256 + wr * 64 + fr, col0 = u.pn * 256 + wc * 32 + 8 * fq;
#pragma unroll
        for (int am = 0; am < 4; ++am) { const int ai = am >> 1, mb = (am & 1) * 2;
            u32x4 pwv[4][2], xwv[4][2]; float rv[4];
#pragma unroll
            for (int m = mb; m < mb + 2; ++m) { rv[m] = rs3[row0 + ai * 128 + m * 16];
#pragma unroll
                for (int bj = 0; bj < 2; ++bj) { const size_t off = (size_t)(row0 + ai * 128 + m * 16) * 1024 + col0 + bj * 128; pwv[m][bj] = *(const u32x4*)(pe + off); xwv[m][bj] = *(const u32x4*)(x2b + off); } }
#pragma unroll
            for (int m = mb; m < mb + 2; ++m) {
                const int row = row0 + ai * 128 + m * 16; const float r = rv[m]; float ss = 0.f;
#pragma unroll
                for (int bj = 0; bj < 2; ++bj) {
                    const size_t off = (size_t)row * 1024 + col0 + bj * 128;
                    const u32x4 pw = pwv[m][bj], xw = xwv[m][bj];
                    const f32x4 x0 = (f32x4){bf_lo(xw.x), bf_hi(xw.x), bf_lo(xw.y), bf_hi(xw.y)}, x1 = (f32x4){bf_lo(xw.z), bf_hi(xw.z), bf_lo(xw.w), bf_hi(xw.w)};
                    const f32x4 a0 = acc[ai][bj][m][0], a1 = acc[ai][bj][m][1];
                    f32x4 o0, o1;
                    o0[0] = x0[0] + bf_lo(pw.x) * fast_sigmoid(a0[0] * r); o0[1] = x0[1] + bf_hi(pw.x) * fast_sigmoid(a0[1] * r);
                    o0[2] = x0[2] + bf_lo(pw.y) * fast_sigmoid(a0[2] * r); o0[3] = x0[3] + bf_hi(pw.y) * fast_sigmoid(a0[3] * r);
                    o1[0] = x1[0] + bf_lo(pw.z) * fast_sigmoid(a1[0] * r); o1[1] = x1[1] + bf_hi(pw.z) * fast_sigmoid(a1[1] * r);
                    o1[2] = x1[2] + bf_lo(pw.w) * fast_sigmoid(a1[2] * r); o1[3] = x1[3] + bf_hi(pw.w) * fast_sigmoid(a1[3] * r);
                    *(u32x4*)(x3b + off) = (u32x4){cvt_pk_bf16(o0[0], o0[1]), cvt_pk_bf16(o0[2], o0[3]), cvt_pk_bf16(o1[0], o1[1]), cvt_pk_bf16(o1[2], o1[3])};
                    ss += ((o0[0] * o0[0] + o0[1] * o0[1]) + (o0[2] * o0[2] + o0[3] * o0[3])) + ((o1[0] * o1[0] + o1[1] * o1[1]) + (o1[2] * o1[2] + o1[3] * o1[3]));
                }
                ss += __shfl_xor(ss, 16); ss += __shfl_xor(ss, 32);
                if (fq == 0) atomicAdd(rowsq + row, (unsigned)(ss * RSQ_FIX + 0.5f));
            }
        }
    }
};

__device__ __forceinline__ int t5_bucket(int rel) {
    const int n = rel < 0 ? -rel : rel; int bkt;
    if (n < 8) bkt = n; else { const int lg = 31 - __clz(n * n); int l = 8 + lg - 6; bkt = l > 15 ? 15 : l; }
    return bkt + (rel > 0 ? 16 : 0);
}
__device__ __forceinline__ void prep_transpose(const float* W, int K, int Nsrc, int col0, int ncols, const float* gk, bf16_t* out, LAS float* tile) {
    const int ntk = K / 64, ntn = ncols / 64;
    for (int t = BIDX(); t < ntk * ntn; t += gridDim.x) {
        const int tk = t % ntk, tn = t / ntk;
        __syncthreads();
        for (int e = TIDX(); e < 4096; e += 512) { const int r = e >> 6, c = e & 63;
            tile[r * 65 + c] = W[(size_t)(tk * 64 + r) * Nsrc + col0 + tn * 64 + c] * (gk ? gk[tk * 64 + r] : 1.f); }
        __syncthreads();
        for (int e = TIDX(); e < 4096; e += 512) { const int r = e >> 6, c = e & 63;
            out[(size_t)(tn * 64 + r) * K + tk * 64 + c] = f2bf(tile[c * 65 + r]); }
    }
}
__device__ __forceinline__ void phase_prep(const Params& P, LAS unsigned char* lds) {
    LAS float* tile = (LAS float*)lds;
    unsigned char* ws = P.ws;
    const size_t gtid = (size_t)BIDX() * 512 + TIDX(), gstride = (size_t)gridDim.x * 512;
    bf16_t* WinT = (bf16_t*)(ws + WS_WIN);
    prep_transpose(P.in[IN_WIN], 1024, 5152, 0, 3072, P.in[IN_N1G], WinT, tile);
    prep_transpose(P.in[IN_WIN], 1024, 5152, 3104, 2048, P.in[IN_N1G], WinT + (size_t)3584 * 1024, tile);
    prep_transpose(P.in[IN_WUPA], 512, 1024, 0, 1024, nullptr, (bf16_t*)(ws + WS_WUP), tile);
    prep_transpose(P.in[IN_WUPB], 512, 1024, 0, 1024, nullptr, (bf16_t*)(ws + WS_WUP) + (size_t)1024 * 512, tile);
    prep_transpose(P.in[IN_WOUT], 1024, 1024, 0, 1024, nullptr, (bf16_t*)(ws + WS_WOUT), tile);
    prep_transpose(P.in[IN_WQ], 1024, 2048, 0, 2048, P.in[IN_N2G], (bf16_t*)(ws + WS_WQ), tile);
    prep_transpose(P.in[IN_PLEG], 1024, 1024, 0, 1024, P.in[IN_N3G], (bf16_t*)(ws + WS_WGATE), tile);
    prep_transpose(P.in[IN_PLEW], 256, 1024, 0, 1024, nullptr, (bf16_t*)(ws + WS_WPLE), tile);
    { const float* win = P.in[IN_WIN]; const float* aw = P.in[IN_AW]; const float* g1 = P.in[IN_N1G];
      for (size_t i = gtid; i < (size_t)512 * 1024; i += gstride) { const int n = (int)(i >> 10), k = (int)(i & 1023), j = n >> 8, c = n & 255;
          const float* wr_ = win + (size_t)k * 5152 + 3072 + 16 * j; const float* ar = aw + (size_t)(j * 16) * 256 + c; float s = 0.f;
#pragma unroll
          for (int r = 0; r < 16; ++r) s += wr_[r] * ar[r * 256];
          WinT[(size_t)(3072 + n) * 1024 + k] = f2bf(s * g1[k]); } }
    { const float* sk = P.in[IN_SK]; bf16_t* o = (bf16_t*)(ws + WS_SK);
      for (size_t i = gtid; i < (size_t)262144 / 4; i += gstride) { const f32x4 v = ((const f32x4*)sk)[i]; u32x2 w; w.x = cvt_pk_bf16(v[0], v[1]); w.y = cvt_pk_bf16(v[2], v[3]); ((u32x2*)o)[i] = w; } }
    { const float* pu = P.in[IN_PU]; const float* pv = P.in[IN_PV]; const float* g2 = P.in[IN_N2G]; unsigned* ub = (unsigned*)(ws + WS_UB); unsigned* vb = (unsigned*)(ws + WS_VB);
      for (size_t i0 = gtid; i0 < (size_t)16384 * 1024 / 16; i0 += gstride) {
          f32x4 ua[2][2], va[2][2];
#pragma unroll
          for (int k = 0; k < 2; ++k) { const size_t i = i0 + k * ((size_t)16384 * 1024 / 16);
              ua[k][0] = ((const f32x4*)pu)[2 * i]; ua[k][1] = ((const f32x4*)pu)[2 * i + 1]; va[k][0] = ((const f32x4*)pv)[2 * i]; va[k][1] = ((const f32x4*)pv)[2 * i + 1]; }
#pragma unroll
          for (int k = 0; k < 2; ++k) { const size_t i = i0 + k * ((size_t)16384 * 1024 / 16); const int d = (int)((i * 8) & 1023);
              const f32x4 g0 = *(const f32x4*)(g2 + d), g1 = *(const f32x4*)(g2 + d + 4); const f32x4 a0 = ua[k][0] * g0 * U_SCALE, a1 = ua[k][1] * g1 * U_SCALE;
              unsigned w = 0u;
#pragma unroll
              for (int j = 0; j < 4; ++j) { const int q0 = (int)__builtin_rintf(fminf(fmaxf(a0[j], -8.f), 7.f)) & 15, q1 = (int)__builtin_rintf(fminf(fmaxf(a1[j], -8.f), 7.f)) & 15;
                  w |= (unsigned)q0 << (4 * j); w |= (unsigned)q1 << (16 + 4 * j); }
              ub[i] = w;
              f32x4 b0 = va[k][0] * V_SCALE, b1 = va[k][1] * V_SCALE;
#pragma unroll
              for (int j = 0; j < 4; ++j) { b0[j] = fminf(fmaxf(b0[j], -6.f), 6.f); b1[j] = fminf(fmaxf(b1[j], -6.f), 6.f); }
              unsigned w2 = 0u;
              w2 = __builtin_amdgcn_cvt_scalef32_pk_fp4_f32(w2, b0[0], b0[1], 1.0f, 0); w2 = __builtin_amdgcn_cvt_scalef32_pk_fp4_f32(w2, b0[2], b0[3], 1.0f, 1);
              w2 = __builtin_amdgcn_cvt_scalef32_pk_fp4_f32(w2, b1[0], b1[1], 1.0f, 2); w2 = __builtin_amdgcn_cvt_scalef32_pk_fp4_f32(w2, b1[2], b1[3], 1.0f, 3);
              vb[i] = w2; } } }
    if (BIDX() == 0) {
        float* sm = (float*)(ws + WS_SMALL);
        for (int i = TIDX(); i < 4 * 257; i += 512) { const int h = i / 257, e = i % 257; sm[h * 260 + e] = P.in[IN_RELB][t5_bucket(e - 128) * 4 + h] * LOG2E; }
        if (TIDX() < 64) { const float* lq = P.in[IN_LQK]; const int l = TIDX();
            const float a = wave_sum(lq[l] * lq[64 + l]), b = wave_sum(lq[128 + l] * lq[192 + l]);
            if (l == 0) sm[SM_LAM] = __expf(a) - __expf(b) + 0.2f; }
    }
}

__device__ __forceinline__ void phase_conv(const Params& P, int g) {
    const int lane = TIDX() & 63, gw = BIDX() * 8 + (TIDX() >> 6), NGW = gridDim.x * 8;
    const float* x = P.in[IN_XP + g]; const float* pp = P.in[IN_PP + g];
    bf16_t* xb = (bf16_t*)(P.ws + A_XBK); bf16_t* pb = (bf16_t*)(P.ws + A_PB); float* rowf = (float*)(P.ws + WS_ROW);
    for (int row0 = gw * 4; row0 < TG; row0 += NGW * 4) {
        f32x4 v[4][4], pv[4];
#pragma unroll
        for (int rr = 0; rr < 4; ++rr) { const f32x4* xr = (const f32x4*)(x + (size_t)(row0 + rr) * 1024) + lane;
#pragma unroll
            for (int j = 0; j < 4; ++j) v[rr][j] = xr[64 * j];
            pv[rr] = ((const f32x4*)(pp + (size_t)(row0 + rr) * 256))[lane]; }
#pragma unroll
        for (int rr = 0; rr < 4; ++rr) { const int row = row0 + rr; float ss = 0.f;
#pragma unroll
            for (int j = 0; j < 4; ++j) ss += (v[rr][j][0] * v[rr][j][0] + v[rr][j][1] * v[rr][j][1]) + (v[rr][j][2] * v[rr][j][2] + v[rr][j][3] * v[rr][j][3]);
            ss = wave_sum(ss);
            u32x2* o = (u32x2*)(xb + (size_t)row * 1024) + lane;
#pragma unroll
            for (int j = 0; j < 4; ++j) { u32x2 w; w.x = cvt_pk_bf16(v[rr][j][0], v[rr][j][1]); w.y = cvt_pk_bf16(v[rr][j][2], v[rr][j][3]); o[64 * j] = w; }
            u32x2 w; w.x = cvt_pk_bf16(pv[rr][0], pv[rr][1]); w.y = cvt_pk_bf16(pv[rr][2], pv[rr][3]);
            ((u32x2*)(pb + (size_t)row * 256))[lane] = w;
            if (lane == 0) { rowf[row] = rsqrtf(ss * (1.f / 1024.f) + EPS); rowf[TG + row] = 0.f; rowf[(3 + g) * TG + row] = 0.f; } }
    }
}

__device__ __forceinline__ float dot2p(unsigned a, unsigned b_pinned, float acc) { asm("" : "+v"(a)); return __builtin_amdgcn_fdot2_f32_bf16(__builtin_bit_cast(bf16x2_t, a), __builtin_bit_cast(bf16x2_t, b_pinned), acc, false); }
__device__ __forceinline__ float dot2w(unsigned a, unsigned b, float acc) { asm("" : "+v"(a)); asm("" : "+v"(b)); return __builtin_amdgcn_fdot2_f32_bf16(__builtin_bit_cast(bf16x2_t, a), __builtin_bit_cast(bf16x2_t, b), acc, false); }

#define ATT_MX3(a, b, c) __builtin_fmaxf(__builtin_fmaxf((a), (b)), (c))
constexpr int ATT_BUF = 32768, ATT_K1 = 0, ATT_K2 = 4096, ATT_V = 16384, ATT_BIAS = 98304, ATT_WS = 99584, ATT_X = 0;
__device__ __forceinline__ void attn_unit(const Params& P, int g, int b, int h, int qb, LAS unsigned char* lds) {
    const int S = g ? 2048 : 4096;
    const int tid = TIDX(), lane = tid & 63, r32 = lane & 31, hi = lane >> 5, wid = __builtin_amdgcn_readfirstlane(tid >> 6), wq = wid & 3, half = wid >> 2;
    const size_t rowbase = (size_t)b * S;
    const unsigned char* Q = P.ws + A_QA + rowbase * 512 + h * 128;
    const unsigned char* K = P.ws + A_KA + rowbase * 512 + h * 128;
    const bf16_t* V = (const bf16_t*)(P.ws + A_VA) + rowbase * 512 + h * 128;
    bf16_t* OA = (bf16_t*)(P.ws + A_OA) + rowbase * 512 + h * 128;
    const float* sm = (const float*)(P.ws + WS_SMALL);
    const int q0 = qb * 128 + wq * 32;
    LAS float* btab = (LAS float*)(lds + ATT_BIAS);
    LAS float* wsf = (LAS float*)(lds + ATT_WS) + wid * 64;
    const unsigned char* ksrc = K + (size_t)(tid >> 3) * 512 + (tid & 7) * 16;
    const bf16_t* vsrc = V + (size_t)(tid >> 4) * 512 + (tid & 15) * 8;
    const int kdst = ((tid & 7) >> 2) * ATT_K2 + (tid >> 3) * 64 + (((tid & 3) ^ ((tid >> 5) & 1)) << 4);
    const int vdst = ATT_V + ((tid & 15) >> 2) * 4096 + (tid >> 4) * 64 + (tid & 3) * 16;
    u32x4 kr0, vr0, vr1;
    kr0 = *(const u32x4*)ksrc; vr0 = *(const u32x4*)vsrc; vr1 = *(const u32x4*)(vsrc + 32 * 512);
    __syncthreads();
    if (tid < 257) btab[tid] = sm[h * 260 + tid];
    *(LAS u32x4*)(lds + kdst) = kr0; *(LAS u32x4*)(lds + vdst) = vr0; *(LAS u32x4*)(lds + vdst + 32 * 64) = vr1;
    i32x8 q;
    { const unsigned char* qrow = Q + (size_t)(q0 + r32) * 512 + half * 64 + 32 * hi; const u32x4 qa = *(const u32x4*)qrow, qb_ = *(const u32x4*)(qrow + 16);
      q = (i32x8){(int)qa.x, (int)qa.y, (int)qa.z, (int)qa.w, (int)qb_.x, (int)qb_.y, (int)qb_.z, (int)qb_.w}; }
    f32x16 o[4];
#pragma unroll
    for (int dq = 0; dq < 4; ++dq)
#pragma unroll
        for (int r = 0; r < 16; ++r) o[dq][r] = 0.f;
    float m = 0.f, l = 0.f;
    unsigned ones2 = 0x3F803F80u; asm volatile("" : "+v"(ones2));
    const int NT = S / 64;
    const int vp_off = ATT_V + ((lane >> 4) & 1) * 32 + (lane & 3) * 8 + (4 * hi + ((lane & 15) >> 2)) * 64;
    const int kp_base = (half ? ATT_K2 : ATT_K1) + r32 * 64, ksw = (r32 >> 2) & 1;
    u32x4 pw[4];
    pw[0] = pw[1] = pw[2] = pw[3] = (u32x4){0u, 0u, 0u, 0u};
#define ATT_PV(BUFP) do { LAS const unsigned char* vb_ = (BUFP); \
        _Pragma("unroll") for (int dh = 0; dh < 2; ++dh) { s16x4 vl[2][4], vh[2][4]; \
            _Pragma("unroll") for (int d2 = 0; d2 < 2; ++d2) _Pragma("unroll") for (int s = 0; s < 4; ++s) { vl[d2][s] = lds_tr(vb_ + vp_off + (2 * dh + d2) * 4096 + s * 1024); vh[d2][s] = lds_tr(vb_ + vp_off + (2 * dh + d2) * 4096 + s * 1024 + 512); } \
            __builtin_amdgcn_sched_barrier(0); \
            _Pragma("unroll") for (int d2 = 0; d2 < 2; ++d2) _Pragma("unroll") for (int s = 0; s < 4; ++s) { \
                const bf16x8 vf = (bf16x8){vl[d2][s][0], vl[d2][s][1], vl[d2][s][2], vl[d2][s][3], vh[d2][s][0], vh[d2][s][1], vh[d2][s][2], vh[d2][s][3]}; \
                o[2 * dh + d2] = MFMA32(__builtin_bit_cast(bf16x8, pw[s]), vf, o[2 * dh + d2]); } } } while (0)
    __syncthreads();
    int slot_c = 0, slot_p = 2, slot_n = 1;
    for (int t = 0; t < NT; ++t) {
        LAS const unsigned char* buf = lds + slot_c * ATT_BUF;
        const bool more = t + 1 < NT;
        if (more) { const size_t adv = (size_t)(t + 1) * 64 * 512;
            kr0 = *(const u32x4*)(ksrc + adv); vr0 = *(const u32x4*)(vsrc + adv); vr1 = *(const u32x4*)(vsrc + adv + 32 * 512); }
        if (half && t > 0) ATT_PV(lds + slot_p * ATT_BUF);
        const int k0 = t * 64;
        const int relmin = k0 - (q0 + 31), relmax = k0 + 63 - q0;
        const int bmode = (relmax <= -91) ? 0 : (relmin >= 91 ? 2 : 1);
        float cb = 0.f;
        if (bmode != 1) cb = (bmode == 0) ? btab[0] : btab[256];
        const float nsub = cb - m;
        f32x16 sA, sB;
#pragma unroll
        for (int r = 0; r < 16; ++r) { sA[r] = nsub; sB[r] = nsub; }
        { const int c0 = ((2 * hi) ^ ksw) << 4, c1 = ((2 * hi + 1) ^ ksw) << 4;
          const u32x4 a0 = *(const LAS u32x4*)(buf + kp_base + c0), a1 = *(const LAS u32x4*)(buf + kp_base + c1), b0 = *(const LAS u32x4*)(buf + kp_base + 2048 + c0), b1 = *(const LAS u32x4*)(buf + kp_base + 2048 + c1);
          __builtin_amdgcn_sched_barrier(0);
          const i32x8 ka = {(int)a0.x, (int)a0.y, (int)a0.z, (int)a0.w, (int)a1.x, (int)a1.y, (int)a1.z, (int)a1.w}, kc = {(int)b0.x, (int)b0.y, (int)b0.z, (int)b0.w, (int)b1.x, (int)b1.y, (int)b1.z, (int)b1.w};
          sA = MFMA_F8(ka, q, sA); sB = MFMA_F8(kc, q, sB); }
        if (bmode == 1) {
            const int relbase = k0 - (q0 + r32);
#pragma unroll
            for (int r = 0; r < 16; ++r) { const int rel = relbase + crow(r, hi);
                const int i0 = min(max(rel, -128), 128) + 128, i1 = min(max(rel + 32, -128), 128) + 128;
                sA[r] += btab[i0]; sB[r] += btab[i1]; }
        }
        if (t == 0 || (t & 3) == 1 || bmode == 1) {
            float mx;
            { float xa = ATT_MX3(sA[0], sA[1], sB[0]), xb = ATT_MX3(sA[2], sA[3], sB[1]); xa = ATT_MX3(xa, sB[2], sB[3]);
#pragma unroll
              for (int r = 4; r < 16; r += 4) { xa = ATT_MX3(xa, sA[r], sA[r + 1]); xb = ATT_MX3(xb, sA[r + 2], sA[r + 3]); xa = ATT_MX3(xa, sB[r], sB[r + 1]); xb = ATT_MX3(xb, sB[r + 2], sB[r + 3]); }
              mx = __builtin_fmaxf(xa, xb); }
            mx = __builtin_fmaxf(mx, __shfl_xor(mx, 32));
            if (t == 0 || __any(mx > 8.f)) {
                const float dl = (t == 0) ? mx : fmaxf(mx, 0.f); m += dl;
                if (t != 0) { const float f = fast_exp2(-dl); l *= f;
                    if (hi == 0) wsf[r32] = f;
                    asm volatile("s_waitcnt lgkmcnt(0)" ::: "memory");
#pragma unroll
                    for (int r = 0; r < 16; ++r) { const float fr_ = wsf[crow(r, hi)];
#pragma unroll
                        for (int dq = 0; dq < 4; ++dq) o[dq][r] *= fr_; } }
#pragma unroll
                for (int r = 0; r < 16; ++r) { sA[r] -= dl; sB[r] -= dl; }
            }
        }
#pragma unroll
        for (int r = 0; r < 16; ++r) { sA[r] = fast_exp2(sA[r]); sB[r] = fast_exp2(sB[r]); }
        pw[0] = (u32x4){cvt_pk_bf16(sA[0], sA[1]), cvt_pk_bf16(sA[2], sA[3]), cvt_pk_bf16(sA[4], sA[5]), cvt_pk_bf16(sA[6], sA[7])};
        pw[1] = (u32x4){cvt_pk_bf16(sA[8], sA[9]), cvt_pk_bf16(sA[10], sA[11]), cvt_pk_bf16(sA[12], sA[13]), cvt_pk_bf16(sA[14], sA[15])};
        pw[2] = (u32x4){cvt_pk_bf16(sB[0], sB[1]), cvt_pk_bf16(sB[2], sB[3]), cvt_pk_bf16(sB[4], sB[5]), cvt_pk_bf16(sB[6], sB[7])};
        pw[3] = (u32x4){cvt_pk_bf16(sB[8], sB[9]), cvt_pk_bf16(sB[10], sB[11]), cvt_pk_bf16(sB[12], sB[13]), cvt_pk_bf16(sB[14], sB[15])};
        { float sa_ = 0.f, sb_ = 0.f;
#pragma unroll
          for (int w4 = 0; w4 < 4; ++w4) { sa_ = dot2p(pw[w4].x, ones2, sa_); sb_ = dot2p(pw[w4].y, ones2, sb_); sa_ = dot2p(pw[w4].z, ones2, sa_); sb_ = dot2p(pw[w4].w, ones2, sb_); }
          l += sa_ + sb_; }
        if (!half) ATT_PV(buf);
        if (more) { LAS unsigned char* nb = lds + slot_n * ATT_BUF;
            *(LAS u32x4*)(nb + kdst) = kr0; *(LAS u32x4*)(nb + vdst) = vr0; *(LAS u32x4*)(nb + vdst + 32 * 64) = vr1; }
        __syncthreads();
        { const int tmp = slot_p; slot_p = slot_c; slot_c = slot_n; slot_n = tmp; }
    }
    if (half) ATT_PV(lds + slot_p * ATT_BUF);
#undef ATT_PV
    l += __shfl_xor(l, 32);
    if (hi == 0) wsf[r32] = (half ? sm[SM_LAM] : 1.f) / l;
    asm volatile("s_waitcnt lgkmcnt(0)" ::: "memory");
    LAS float* xch = (LAS float*)(lds + ATT_X) + wq * (32 * 132);
#pragma unroll
    for (int r = 0; r < 16; ++r) { const float a = wsf[crow(r, hi)];
#pragma unroll
        for (int dq = 0; dq < 4; ++dq) o[dq][r] *= a; }
    __syncthreads();
    if (half) {
#pragma unroll
        for (int r = 0; r < 16; ++r)
#pragma unroll
            for (int dq = 0; dq < 4; ++dq) xch[crow(r, hi) * 132 + 32 * dq + r32] = o[dq][r];
    }
    __syncthreads();
    if (!half) {
        const float* dag = P.in[IN_DAG];
        float gq[4];
#pragma unroll
        for (int dq = 0; dq < 4; ++dq) gq[dq] = dag[32 * dq + r32] * 0.8f;
#pragma unroll
        for (int r = 0; r < 16; ++r) {
            float ov[4]; float ss = 0.f;
#pragma unroll
            for (int dq = 0; dq < 4; ++dq) { ov[dq] = o[dq][r] - xch[crow(r, hi) * 132 + 32 * dq + r32]; ss += ov[dq] * ov[dq]; }
#pragma unroll
            for (int of_ = 1; of_ < 32; of_ <<= 1) ss += __shfl_xor(ss, of_);
            const float sc = rsqrtf(ss * (1.f / 128.f) + EPS);
            bf16_t* orow = OA + (size_t)(q0 + crow(r, hi)) * 512 + r32;
#pragma unroll
            for (int dq = 0; dq < 4; ++dq) orow[32 * dq] = f2bf(ov[dq] * sc * gq[dq]);
        }
    }
}

constexpr int G_Q = 0, G_KE = 9216, G_KDT = 18432, G_ATT = 27648, G_V = 36864, G_DEC = 55296;
__device__ __forceinline__ float wave_prefix_sum(float v) {
    v += __builtin_bit_cast(float, __builtin_amdgcn_update_dpp(0, __builtin_bit_cast(int, v), 0x111, 0xf, 0xf, true));
    v += __builtin_bit_cast(float, __builtin_amdgcn_update_dpp(0, __builtin_bit_cast(int, v), 0x112, 0xf, 0xf, true));
    v += __builtin_bit_cast(float, __builtin_amdgcn_update_dpp(0, __builtin_bit_cast(int, v), 0x114, 0xf, 0xf, true));
    v += __builtin_bit_cast(float, __builtin_amdgcn_update_dpp(0, __builtin_bit_cast(int, v), 0x118, 0xf, 0xf, true));
    v += __builtin_bit_cast(float, __builtin_amdgcn_update_dpp(0, __builtin_bit_cast(int, v), 0x142, 0xa, 0xf, false));
    v += __builtin_bit_cast(float, __builtin_amdgcn_update_dpp(0, __builtin_bit_cast(int, v), 0x143, 0xc, 0xf, false));
    return v;
}
__device__ __forceinline__ void gla_item(const Params& P, int g, int item, LAS unsigned char* lds) {
    const int S = g ? 2048 : 4096;
    const int dir = item & 1, h = (item >> 1) & 3, b = item >> 3;
    const int tid = TIDX(), lane = tid & 63, wid = tid >> 6, q4 = lane >> 4, l15 = lane & 15;
    const size_t rowbase = (size_t)b * S;
    const bf16_t* QG = (const bf16_t*)(P.ws + A_QG) + rowbase * 256 + h * 8 * 512;
    const bf16_t* KG = (const bf16_t*)(P.ws + A_KG) + rowbase * 256 + h * 8 * 512;
    const bf16_t* VG = (const bf16_t*)(P.ws + A_VG) + rowbase * 512 + h * 128;
    const bf16_t* LA = (const bf16_t*)(P.ws + A_LA) + rowbase * 512 + (dir * 32 + h * 8) * 512;
    bf16_t* OD = (bf16_t*)(P.ws + (dir ? A_OB : A_OF)) + rowbase * 512 + h * 128;
    LAS float* Ldec = (LAS float*)(lds + G_DEC);
    f32x4 st[4];
#pragma unroll
    for (int kb = 0; kb < 4; ++kb) st[kb] = (f32x4){0.f, 0.f, 0.f, 0.f};
    const int nc = S / 64;
    const int kc = wid * 8;
    u32x4 qv, kv, lav, vv[2];
#define GLA_ISSUE(cc) { const size_t tn = (size_t)(cc) * 64; \
        qv = *(const u32x4*)(QG + tn * 256 + (size_t)(kc >> 3) * 512 + lane * 8); kv = *(const u32x4*)(KG + tn * 256 + (size_t)(kc >> 3) * 512 + lane * 8); \
        lav = *(const u32x4*)(LA + tn * 512 + (size_t)(kc >> 3) * 512 + lane * 8); \
        _Pragma("unroll") for (int i = 0; i < 2; ++i) { const int pidx = tid + i * 512; vv[i] = *(const u32x4*)(VG + (tn + (pidx >> 4)) * 512 + (pidx & 15) * 8); } }
#define GLA_BAR { asm volatile("s_waitcnt lgkmcnt(0)" ::: "memory"); __builtin_amdgcn_s_barrier(); asm volatile("" ::: "memory"); }
    GLA_ISSUE(dir ? nc - 1 : 0)
    for (int n = 0; n < nc; ++n) {
        const int c = dir ? (nc - 1 - n) : n; const size_t t0 = (size_t)c * 64;
        float la[8], bb[8], tot[8], qf[8], kf[8];
        la[0] = bf_lo(lav.x); la[1] = bf_hi(lav.x); la[2] = bf_lo(lav.y); la[3] = bf_hi(lav.y); la[4] = bf_lo(lav.z); la[5] = bf_hi(lav.z); la[6] = bf_lo(lav.w); la[7] = bf_hi(lav.w);
#pragma unroll
        for (int j = 0; j < 8; ++j) { const float pre = wave_prefix_sum(la[j]);
            tot[j] = __builtin_bit_cast(float, __builtin_amdgcn_readlane(__builtin_bit_cast(int, pre), 63));
            bb[j] = dir == 0 ? pre : tot[j] - pre + la[j]; }
        qf[0] = bf_lo(qv.x); qf[1] = bf_hi(qv.x); qf[2] = bf_lo(qv.y); qf[3] = bf_hi(qv.y); qf[4] = bf_lo(qv.z); qf[5] = bf_hi(qv.z); qf[6] = bf_lo(qv.w); qf[7] = bf_hi(qv.w);
        kf[0] = bf_lo(kv.x); kf[1] = bf_hi(kv.x); kf[2] = bf_lo(kv.y); kf[3] = bf_hi(kv.y); kf[4] = bf_lo(kv.z); kf[5] = bf_hi(kv.z); kf[6] = bf_lo(kv.w); kf[7] = bf_hi(kv.w);
        float qe[8], ke[8], kd[8];
#pragma unroll
        for (int j = 0; j < 8; ++j) { qe[j] = qf[j] * __expf(bb[j]); ke[j] = kf[j] * __expf(-bb[j]); kd[j] = kf[j] * __expf(tot[j] - bb[j]); }
        GLA_BAR
#pragma unroll
        for (int i = 0; i < 2; ++i) { const int pidx = tid + i * 512; *(LAS u32x4*)(lds + G_V + (pidx >> 4) * 288 + (pidx & 15) * 16) = vv[i]; }
#pragma unroll
        for (int j = 0; j < 8; ++j) *(LAS bf16_t*)(lds + G_KDT + (kc + j) * 144 + lane * 2) = f2bf(kd[j]);
        *(LAS u32x4*)(lds + G_Q + lane * 144 + kc * 2) = (u32x4){cvt_pk_bf16(qe[0], qe[1]), cvt_pk_bf16(qe[2], qe[3]), cvt_pk_bf16(qe[4], qe[5]), cvt_pk_bf16(qe[6], qe[7])};
        *(LAS u32x4*)(lds + G_KE + lane * 144 + kc * 2) = (u32x4){cvt_pk_bf16(ke[0], ke[1]), cvt_pk_bf16(ke[2], ke[3]), cvt_pk_bf16(ke[4], ke[5]), cvt_pk_bf16(ke[6], ke[7])};
        if (lane < 8) { float tj = tot[0];
#pragma unroll
            for (int j = 1; j < 8; ++j) tj = lane == j ? tot[j] : tj;
            Ldec[kc + lane] = __expf(tj); }
        if (n + 1 < nc) GLA_ISSUE(dir ? (nc - 2 - n) : (n + 1))
        GLA_BAR
        { const int tb = wid >> 1;
#pragma unroll
          for (int i = 0; i < 2; ++i) { const int sb = (wid & 1) * 2 + i; f32x4 acc = (f32x4){0.f, 0.f, 0.f, 0.f};
#pragma unroll
              for (int ks = 0; ks < 2; ++ks) {
                  const bf16x8 af = *(const LAS bf16x8*)(lds + G_Q + (16 * tb + l15) * 144 + (32 * ks + 8 * q4) * 2);
                  const bf16x8 bf = *(const LAS bf16x8*)(lds + G_KE + (16 * sb + l15) * 144 + (32 * ks + 8 * q4) * 2);
                  acc = MFMA16(af, bf, acc); }
              const int s_ = 16 * sb + l15;
#pragma unroll
              for (int r = 0; r < 4; ++r) { const int t_ = 16 * tb + 4 * q4 + r; const bool keep = dir == 0 ? (s_ <= t_) : (s_ > t_);
                  *(LAS bf16_t*)(lds + G_ATT + t_ * 144 + s_ * 2) = f2bf(keep ? acc[r] : 0.f); } } }
        GLA_BAR
        bf16x8 vf[2];
#pragma unroll
        for (int ks = 0; ks < 2; ++ks) { LAS const unsigned char* ap = lds + G_V + (32 * ks + 8 * q4 + (l15 >> 2)) * 288 + (16 * wid + (l15 & 3) * 4) * 2;
            const s16x4 lo = lds_tr(ap), hi4 = lds_tr(ap + 4 * 288); vf[ks] = (bf16x8){lo[0], lo[1], lo[2], lo[3], hi4[0], hi4[1], hi4[2], hi4[3]}; }
        bf16x8 sf[2];
#pragma unroll
        for (int ks = 0; ks < 2; ++ks) { const u32x4 w = (u32x4){cvt_pk_bf16(st[2 * ks][0], st[2 * ks][1]), cvt_pk_bf16(st[2 * ks][2], st[2 * ks][3]), cvt_pk_bf16(st[2 * ks + 1][0], st[2 * ks + 1][1]), cvt_pk_bf16(st[2 * ks + 1][2], st[2 * ks + 1][3])};
            sf[ks] = __builtin_bit_cast(bf16x8, w); }
#pragma unroll
        for (int tb = 0; tb < 4; ++tb) { f32x4 acc = (f32x4){0.f, 0.f, 0.f, 0.f};
#pragma unroll
            for (int ks = 0; ks < 2; ++ks) { const bf16x8 af = *(const LAS bf16x8*)(lds + G_ATT + (16 * tb + l15) * 144 + (32 * ks + 8 * q4) * 2); acc = MFMA16(vf[ks], af, acc); }
#pragma unroll
            for (int ks = 0; ks < 2; ++ks) { const s16x4 a0 = *(const LAS s16x4*)(lds + G_Q + (16 * tb + l15) * 144 + (32 * ks + 4 * q4) * 2), a1 = *(const LAS s16x4*)(lds + G_Q + (16 * tb + l15) * 144 + (32 * ks + 16 + 4 * q4) * 2);
                const bf16x8 af = (bf16x8){a0[0], a0[1], a0[2], a0[3], a1[0], a1[1], a1[2], a1[3]}; acc = MFMA16(sf[ks], af, acc); }
            *(u32x2*)(OD + (t0 + 16 * tb + l15) * 512 + 16 * wid + 4 * q4) = (u32x2){cvt_pk_bf16(acc[0], acc[1]), cvt_pk_bf16(acc[2], acc[3])}; }
#pragma unroll
        for (int kb = 0; kb < 4; ++kb) { const f32x4 dc = *(const LAS f32x4*)(Ldec + 16 * kb + 4 * q4); st[kb] = st[kb] * dc;
#pragma unroll
            for (int ks = 0; ks < 2; ++ks) { const bf16x8 af = *(const LAS bf16x8*)(lds + G_KDT + (16 * kb + l15) * 144 + (32 * ks + 8 * q4) * 2); st[kb] = MFMA16(af, vf[ks], st[kb]); } }
    }
}
constexpr size_t WS_QUEUE = 16384;
__device__ __forceinline__ void phase_mix(const Params& P, int g, LAS unsigned char* lds) {
    const int B = g ? 16 : 8, S = g ? 2048 : 4096; const int nG = B * 8, nQ = S / 128, nA = B * 4 * nQ;
    const int G = gridDim.x, bx = BIDX();
    for (int i = bx; i < nG; i += G) gla_item(P, g, i, lds);
    unsigned* queues = (unsigned*)(P.ws + WS_CTL + WS_QUEUE) + g * 8 * 16;
    const int per_q = nA / 8;
    volatile LAS int* slot = (volatile LAS int*)(lds + LDSCTL_OFF + 64);
    int x = bx & 7, tries = 0;
    for (;;) {
        __syncthreads();
        if (threadIdx.x == 0) slot[0] = (int)__hip_atomic_fetch_add(queues + x * 16, 1u, __ATOMIC_RELAXED, __HIP_MEMORY_SCOPE_AGENT);
        __syncthreads();
        const int j = __builtin_amdgcn_readfirstlane(slot[0]);
        if (j >= per_q) { if (++tries == 8) break; x = (x + 1) & 7; continue; }
        const int bh = x + 8 * (j / nQ), qb = j % nQ;
        attn_unit(P, g, bh >> 2, bh & 3, qb, lds);
    }
}

__device__ __forceinline__ void phase_ogfix(const Params& P, int g) {
    const int lane = TIDX() & 63, gw = BIDX() * 8 + (TIDX() >> 6), NGW = gridDim.x * 8;
    const bf16_t* of = (const bf16_t*)(P.ws + A_OF); const bf16_t* ob = (const bf16_t*)(P.ws + A_OB); const bf16_t* rgs = (const bf16_t*)(P.ws + A_RGS); bf16_t* og = (bf16_t*)(P.ws + A_OG);
    const float* gg = P.in[IN_GLAG];
    float gv[8];
#pragma unroll
    for (int j = 0; j < 8; ++j) gv[j] = gg[(lane & 15) * 8 + j];
    for (int row0 = gw * 4; row0 < TG; row0 += NGW * 4) {
        u32x4 a4[4], b4[4], r4[4];
#pragma unroll
        for (int rr = 0; rr < 4; ++rr) { const size_t row = row0 + rr; a4[rr] = ((const u32x4*)(of + row * 512))[lane]; b4[rr] = ((const u32x4*)(ob + row * 512))[lane]; r4[rr] = ((const u32x4*)(rgs + row * 512))[lane]; }
#pragma unroll
        for (int rr = 0; rr < 4; ++rr) { const size_t row = row0 + rr; const u32x4 a = a4[rr], b = b4[rr], r = r4[rr];
            float v[8];
            v[0] = bf_lo(a.x) + bf_lo(b.x); v[1] = bf_hi(a.x) + bf_hi(b.x); v[2] = bf_lo(a.y) + bf_lo(b.y); v[3] = bf_hi(a.y) + bf_hi(b.y);
            v[4] = bf_lo(a.z) + bf_lo(b.z); v[5] = bf_hi(a.z) + bf_hi(b.z); v[6] = bf_lo(a.w) + bf_lo(b.w); v[7] = bf_hi(a.w) + bf_hi(b.w);
            float ss = 0.f;
#pragma unroll
            for (int j = 0; j < 8; ++j) ss += v[j] * v[j];
#pragma unroll
            for (int o = 1; o < 16; o <<= 1) ss += __shfl_xor(ss, o);
            const float sc = rsqrtf(ss * (1.f / 128.f) + EPS);
            const float rv[8] = {bf_lo(r.x), bf_hi(r.x), bf_lo(r.y), bf_hi(r.y), bf_lo(r.z), bf_hi(r.z), bf_lo(r.w), bf_hi(r.w)};
#pragma unroll
            for (int j = 0; j < 8; ++j) v[j] = v[j] * sc * gv[j] * rv[j];
            ((u32x4*)(og + row * 512))[lane] = (u32x4){cvt_pk_bf16(v[0], v[1]), cvt_pk_bf16(v[2], v[3]), cvt_pk_bf16(v[4], v[5]), cvt_pk_bf16(v[6], v[7])}; }
    }
}

__device__ __forceinline__ unsigned f2sort(float f) { const unsigned u = __float_as_uint(f); return (u & 0x80000000u) ? ~u : (u | 0x80000000u); }
__device__ __forceinline__ float sort2f(unsigned s) { const unsigned u = (s & 0x80000000u) ? (s & 0x7fffffffu) : ~s; return __uint_as_float(u); }
__device__ __forceinline__ void ce_desc(unsigned& a, unsigned& b) { const unsigned h = max(a, b), l = min(a, b); a = h; b = l; }
__device__ __forceinline__ void bitonic_merge16(unsigned (&a)[16]) {
#pragma unroll
    for (int j = 8; j > 0; j >>= 1)
#pragma unroll
        for (int i = 0; i < 16; ++i) { const int l = i ^ j; if (l > i) ce_desc(a[i], a[l]); }
}
__device__ __forceinline__ void bitonic_sort16(unsigned (&a)[16]) {
#define CE_(i, j) ce_desc(a[i], a[j]);
    CE_(0,13) CE_(1,12) CE_(2,15) CE_(3,14) CE_(4,8) CE_(5,6) CE_(7,11) CE_(9,10)
    CE_(0,5) CE_(1,7) CE_(2,9) CE_(3,4) CE_(6,13) CE_(8,14) CE_(10,15) CE_(11,12)
    CE_(0,1) CE_(2,3) CE_(4,5) CE_(6,8) CE_(7,9) CE_(10,11) CE_(12,13) CE_(14,15)
    CE_(0,2) CE_(1,3) CE_(4,10) CE_(5,11) CE_(6,7) CE_(8,9) CE_(12,14) CE_(13,15)
    CE_(1,2) CE_(3,12) CE_(4,6) CE_(5,7) CE_(8,10) CE_(9,11) CE_(13,14)
    CE_(1,4) CE_(2,6) CE_(5,8) CE_(7,10) CE_(9,13) CE_(11,14)
    CE_(2,4) CE_(3,6) CE_(9,12) CE_(11,13)
    CE_(3,5) CE_(6,8) CE_(7,9) CE_(10,12)
    CE_(3,4) CE_(5,6) CE_(7,8) CE_(9,10) CE_(11,12)
    CE_(6,7) CE_(8,9)
#undef CE_
}
__device__ __forceinline__ void top16_merge(unsigned (&L)[16], const unsigned (&N)[16]) {
#pragma unroll
    for (int i = 0; i < 16; ++i) L[i] = max(L[i], N[15 - i]);
    bitonic_merge16(L);
}
__device__ __forceinline__ void topk_half(const bf16x8 (&bq)[8], LAS const unsigned char* kp, int hi, unsigned (&L)[16]) {
#pragma unroll 1
    for (int kb = 0; kb < 4; ++kb) {
        f32x16 acc;
#pragma unroll
        for (int r = 0; r < 16; ++r) acc[r] = 0.f;
#pragma unroll
        for (int ks = 0; ks < 8; ++ks) { const bf16x8 ak = *(const LAS bf16x8*)(kp + ks * 4096 + kb * 512); acc = MFMA32(ak, bq[ks], acc); }
        unsigned N[16];
#pragma unroll
        for (int r = 0; r < 16; ++r) { const unsigned idx = 32 * kb + crow(r, hi); N[r] = (f2sort(acc[r]) & ~127u) | (127u - idx); }
        bitonic_sort16(N);
        if (kb == 0) {
#pragma unroll
            for (int r = 0; r < 16; ++r) L[r] = N[r];
        } else top16_merge(L, N);
    }
    unsigned O[16];
#pragma unroll
    for (int j = 0; j < 16; ++j) O[j] = __shfl_xor(L[j], 32);
    top16_merge(L, O);
}
__device__ __forceinline__ void phase_topk(const Params& P, int g, LAS unsigned char* lds) {
    const int tid = TIDX(), lane = tid & 63, r32 = lane & 31, hi = lane >> 5, wid = tid >> 6;
    const bf16_t* Q = (const bf16_t*)(P.ws + A_Q); const bf16_t* SK = (const bf16_t*)(P.ws + WS_SK);
    unsigned short* IDX = (unsigned short*)(P.ws + A_IDX); float* GW = (float*)(P.ws + A_GW);
    LAS unsigned char* sc = lds + 65536 + wid * 1024 + r32 * 32;
    const int G = gridDim.x, bx = BIDX(); const bool split = (G & 7) == 0;
    const int nworkers = (split ? G / 8 : G) * 8, worker = (split ? (bx >> 3) : bx) * 8 + wid;
  for (int hd = 0; hd < 8; ++hd) {
    if (split && (bx & 7) != hd) continue;
    __syncthreads();
    for (int e = tid; e < 4096; e += 512) { const int c = e >> 11, n = (e >> 4) & 127, ch = e & 15;
        *(LAS u32x4*)(lds + c * 32768 + ch * 2048 + n * 16) = *(const u32x4*)(SK + ((size_t)(hd * 2 + c) * 128 + n) * 128 + ch * 8); }
    __syncthreads();
    for (int tb = worker; tb < TG / 32; tb += nworkers) {
        const int tok0 = tb * 32;
        unsigned LA_[16], LB_[16];
        bf16x8 bqa[8], bqb[8];
        { const bf16_t* qp = Q + (size_t)(tok0 + r32) * 2048 + hd * 256 + 8 * hi;
#pragma unroll
          for (int ks = 0; ks < 8; ++ks) { bqa[ks] = *(const bf16x8*)(qp + 16 * ks); bqb[ks] = *(const bf16x8*)(qp + 128 + 16 * ks); } }
        topk_half(bqa, lds + hi * 2048 + r32 * 16, hi, LA_);
        topk_half(bqb, lds + 32768 + hi * 2048 + r32 * 16, hi, LB_);
        float va[16], vb[16];
#pragma unroll
        for (int j = 0; j < 16; ++j) { va[j] = sort2f(LA_[j] & ~127u); vb[j] = sort2f(LB_[j] & ~127u); }
        unsigned L2[16];
        {
            constexpr int NC = 50;
            constexpr unsigned char CI[64] = {0,0,0,0,0,0,0,0,0,0,0,0,0,0,0,0, 1,1,1,1,1,1,1,1, 2,2,2,2,2, 3,3,3,3, 4,4,4, 5,5, 6,6, 7,7, 8,9,10,11,12,13,14,15, 0,0,0,0,0,0,0,0,0,0,0,0,0,0};
            constexpr unsigned char CJ[64] = {0,1,2,3,4,5,6,7,8,9,10,11,12,13,14,15, 0,1,2,3,4,5,6,7, 0,1,2,3,4, 0,1,2,3, 0,1,2, 0,1, 0,1, 0,1, 0,0,0,0,0,0,0,0, 0,0,0,0,0,0,0,0,0,0,0,0,0,0};
#pragma unroll
            for (int gq = 0; gq < 4; ++gq) {
                unsigned N[16];
#pragma unroll
                for (int c = 0; c < 16; ++c) { const int ci = 16 * gq + c; N[c] = (ci < NC) ? ((f2sort(va[CI[ci]] + vb[CJ[ci]]) & ~255u) | (unsigned)(CI[ci] * 16 + CJ[ci])) : 0u; }
                bitonic_sort16(N);
                if (gq == 0) {
#pragma unroll
                    for (int c = 0; c < 16; ++c) L2[c] = N[c];
                } else top16_merge(L2, N);
            }
        }
        if (hi == 0) {
#pragma unroll
            for (int j = 0; j < 16; ++j) { sc[j] = (unsigned char)(127u - (LA_[j] & 127u)); sc[16 + j] = (unsigned char)(127u - (LB_[j] & 127u)); }
        }
        asm volatile("s_waitcnt lgkmcnt(0)" ::: "memory");
        float e[16]; float sum = 0.f; const float v0 = sort2f(L2[0] & ~255u);
#pragma unroll
        for (int k = 0; k < 16; ++k) { e[k] = __expf(sort2f(L2[k] & ~255u) - v0); sum += e[k]; }
        const float inv = 1.f / sum;
        const size_t ob = (size_t)(tok0 + r32) * 128 + hd * 16;
        if (hi == 0) {
            unsigned ids[16];
#pragma unroll
            for (int k = 0; k < 16; ++k) { const unsigned key = L2[k]; const int i = (key >> 4) & 15, j = key & 15; const unsigned ia = sc[i], ib = sc[16 + j]; ids[k] = ia * 128u + ib; }
            *(u32x4*)(IDX + ob) = (u32x4){ids[0] | (ids[1] << 16), ids[2] | (ids[3] << 16), ids[4] | (ids[5] << 16), ids[6] | (ids[7] << 16)};
            *(u32x4*)(IDX + ob + 8) = (u32x4){ids[8] | (ids[9] << 16), ids[10] | (ids[11] << 16), ids[12] | (ids[13] << 16), ids[14] | (ids[15] << 16)};
        } else {
#pragma unroll
            for (int k = 0; k < 4; ++k) *(f32x4*)(GW + ob + 4 * k) = (f32x4){e[4 * k] * inv, e[4 * k + 1] * inv, e[4 * k + 2] * inv, e[4 * k + 3] * inv};
        }
        asm volatile("s_waitcnt lgkmcnt(0)" ::: "memory");
    }
  }
}

constexpr int GQ_SCHED = 0, GQ_CNT = 4224, GQ_CUR = 4480, GQ_WAVE = 4736;
constexpr int GA_D = 4;
__device__ __forceinline__ float dpp_row_sum(float v) {
    v += __builtin_bit_cast(float, __builtin_amdgcn_update_dpp(0, __builtin_bit_cast(int, v), 0xB1, 0xf, 0xf, true));
    v += __builtin_bit_cast(float, __builtin_amdgcn_update_dpp(0, __builtin_bit_cast(int, v), 0x4E, 0xf, 0xf, true));
    v += __builtin_bit_cast(float, __builtin_amdgcn_update_dpp(0, __builtin_bit_cast(int, v), 0x141, 0xf, 0xf, true));
    v += __builtin_bit_cast(float, __builtin_amdgcn_update_dpp(0, __builtin_bit_cast(int, v), 0x140, 0xf, 0xf, true));
    return v;
}
__device__ __forceinline__ void phase_gather(const Params& P, int g, LAS unsigned char* lds) {
    const int tid = TIDX(), lane = tid & 63, wid = __builtin_amdgcn_readfirstlane(tid >> 6), q = lane >> 4, j = lane & 15;
    float* xo = P.out + (size_t)g * TG * 1024;
    const bf16_t* x1b = (const bf16_t*)(P.ws + A_X1B); bf16_t* x2b = (bf16_t*)(P.ws + A_X2B);
    const unsigned short* IDX = (const unsigned short*)(P.ws + A_IDX); const float* GW = (const float*)(P.ws + A_GW);
    const unsigned char* Ub = P.ws + WS_UB + j * 16; const unsigned char* Vb = P.ws + WS_VB + j * 16;
    float* rowf = (float*)(P.ws + WS_ROW);
    LAS unsigned char* wl = lds + wid * GQ_WAVE;
    LAS unsigned* cnt = (LAS unsigned*)(wl + GQ_CNT); LAS unsigned* cur = (LAS unsigned*)(wl + GQ_CUR);
    LAS u32x2* sched = (LAS u32x2*)(wl + GQ_SCHED) + q * 128;
    const int G = gridDim.x, b = BIDX();
    for (int bi = b; bi < TG / 32; bi += G) {
        const int tok = bi * 32 + wid * 4 + q;
        cnt[lane] = 0u;
        u32x4 ei = *(const u32x4*)(IDX + (size_t)tok * 128 + j * 8);
        f32x4 eg0 = *(const f32x4*)(GW + (size_t)tok * 128 + j * 8), eg1 = *(const f32x4*)(GW + (size_t)tok * 128 + j * 8 + 4);
        unsigned eidx[8]; float egt[8];
        eidx[0] = ei.x & 0xffffu; eidx[1] = ei.x >> 16; eidx[2] = ei.y & 0xffffu; eidx[3] = ei.y >> 16; eidx[4] = ei.z & 0xffffu; eidx[5] = ei.z >> 16; eidx[6] = ei.w & 0xffffu; eidx[7] = ei.w >> 16;
        egt[0] = eg0[0]; egt[1] = eg0[1]; egt[2] = eg0[2]; egt[3] = eg0[3]; egt[4] = eg1[0]; egt[5] = eg1[1]; egt[6] = eg1[2]; egt[7] = eg1[3];
        const float rs = rsqrtf((float)__float_as_uint(rowf[TG + tok]) * RSQ_INV * (1.f / 1024.f) + EPS) * (1.f / U_SCALE);
        asm volatile("s_waitcnt lgkmcnt(0)" ::: "memory");
#pragma unroll
        for (int k = 0; k < 8; ++k) __hip_atomic_fetch_add(cnt + (q * 16 + (eidx[k] >> 10)), 1u, __ATOMIC_RELAXED, __HIP_MEMORY_SCOPE_WORKGROUP);
        asm volatile("s_waitcnt lgkmcnt(0)" ::: "memory");
        { const unsigned c0 = cnt[lane]; unsigned incl = c0;
#pragma unroll
          for (int o = 1; o < 64; o <<= 1) { const unsigned t = __shfl_up(incl, o); if (lane >= o) incl += t; }
          cur[lane] = incl - c0; }
        asm volatile("s_waitcnt lgkmcnt(0)" ::: "memory");
#pragma unroll
        for (int k = 0; k < 8; ++k) { const unsigned pos = __hip_atomic_fetch_add(cur + (q * 16 + (eidx[k] >> 10)), 1u, __ATOMIC_RELAXED, __HIP_MEMORY_SCOPE_WORKGROUP);
            ((LAS u32x2*)(wl + GQ_SCHED))[pos] = (u32x2){eidx[k], __float_as_uint(egt[k] * (1.f / V_SCALE))}; }
        if (lane < 8) ((LAS u32x2*)(wl + GQ_SCHED))[512 + lane] = (u32x2){0u, 0u};
        asm volatile("s_waitcnt lgkmcnt(0)" ::: "memory");
        typedef _Float16 h16x2 __attribute__((ext_vector_type(2)));
        h16x2 acc[8][4];
#pragma unroll
        for (int c8 = 0; c8 < 8; ++c8)
#pragma unroll
            for (int c = 0; c < 4; ++c) acc[c8][c] = (h16x2){(_Float16)0.f, (_Float16)0.f};
        {
            int hq[8]; float hmaxv = 0.f; float hv[64];
            { const u32x4* row = (const u32x4*)(x1b + (size_t)tok * 1024 + 64 * j);
#pragma unroll
              for (int c8 = 0; c8 < 8; ++c8) { const u32x4 r = row[c8];
                  hv[8 * c8 + 0] = bf_lo(r.x); hv[8 * c8 + 1] = bf_hi(r.x); hv[8 * c8 + 2] = bf_lo(r.y); hv[8 * c8 + 3] = bf_hi(r.y); hv[8 * c8 + 4] = bf_lo(r.z); hv[8 * c8 + 5] = bf_hi(r.z); hv[8 * c8 + 6] = bf_lo(r.w); hv[8 * c8 + 7] = bf_hi(r.w); } }
#pragma unroll
            for (int c = 0; c < 64; ++c) hmaxv = fmaxf(hmaxv, fabsf(hv[c]));
            hmaxv = fmaxf(hmaxv, __builtin_bit_cast(float, __builtin_amdgcn_update_dpp(0, __builtin_bit_cast(int, hmaxv), 0xB1, 0xf, 0xf, true)));
            hmaxv = fmaxf(hmaxv, __builtin_bit_cast(float, __builtin_amdgcn_update_dpp(0, __builtin_bit_cast(int, hmaxv), 0x4E, 0xf, 0xf, true)));
            hmaxv = fmaxf(hmaxv, __builtin_bit_cast(float, __builtin_amdgcn_update_dpp(0, __builtin_bit_cast(int, hmaxv), 0x141, 0xf, 0xf, true)));
            hmaxv = fmaxf(hmaxv, __builtin_bit_cast(float, __builtin_amdgcn_update_dpp(0, __builtin_bit_cast(int, hmaxv), 0x140, 0xf, 0xf, true)));
            hmaxv = fmaxf(hmaxv, 1e-20f);
            const float hstep = 0.335f * __builtin_amdgcn_rcpf(rs * U_SCALE); const float hsc = __builtin_amdgcn_rcpf(hstep), rsq = rs * hstep;
#pragma unroll
            for (int c8 = 0; c8 < 8; ++c8) { unsigned w = 0u;
#pragma unroll
                for (int c = 0; c < 8; ++c) { const int qv = (int)__builtin_rintf(fminf(fmaxf(hv[8 * c8 + c] * hsc, -8.f), 7.f)); w |= (unsigned)(qv & 15) << (4 * c); }
                hq[c8] = (int)w; }
            const unsigned char* Ub4 = P.ws + WS_UB + j * 32; const unsigned char* Vb4 = P.ws + WS_VB + j * 32;
            u32x4 U[GA_D][2], V[GA_D][2];
#pragma unroll
            for (int d = 0; d < GA_D; ++d) { const size_t ro = (size_t)sched[d].x * 512; U[d][0] = ((const u32x4*)(Ub4 + ro))[0]; U[d][1] = ((const u32x4*)(Ub4 + ro))[1]; V[d][0] = ((const u32x4*)(Vb4 + ro))[0]; V[d][1] = ((const u32x4*)(Vb4 + ro))[1]; }
#pragma unroll 1
            for (int k0 = 0; k0 < 128; k0 += GA_D) {
#pragma unroll
                for (int d = 0; d < GA_D; ++d) {
                    const float gate = __uint_as_float(sched[k0 + d].y);
                    const u32x4 u0 = U[d][0], u1 = U[d][1], v0 = V[d][0], v1 = V[d][1];
                    { const size_t ro = (size_t)sched[k0 + d + GA_D].x * 512; U[d][0] = ((const u32x4*)(Ub4 + ro))[0]; U[d][1] = ((const u32x4*)(Ub4 + ro))[1]; V[d][0] = ((const u32x4*)(Vb4 + ro))[0]; V[d][1] = ((const u32x4*)(Vb4 + ro))[1]; }
                    int ia = 0, ib = 0;
                    ia = __builtin_amdgcn_sdot8((int)u0.x, hq[0], ia, false); ib = __builtin_amdgcn_sdot8((int)u0.y, hq[1], ib, false); ia = __builtin_amdgcn_sdot8((int)u0.z, hq[2], ia, false); ib = __builtin_amdgcn_sdot8((int)u0.w, hq[3], ib, false);
                    ia = __builtin_amdgcn_sdot8((int)u1.x, hq[4], ia, false); ib = __builtin_amdgcn_sdot8((int)u1.y, hq[5], ib, false); ia = __builtin_amdgcn_sdot8((int)u1.z, hq[6], ia, false); ib = __builtin_amdgcn_sdot8((int)u1.w, hq[7], ib, false);
                    const float x = dpp_row_sum((float)(ia + ib)) * rsq;
                    const float e = fast_exp2(x * (-2.3022082f + -0.10294324f * x * x));
                    const _Float16 wh = (_Float16)(gate * x * __builtin_amdgcn_rcpf(1.f + e) * 16.f); const h16x2 w2 = (h16x2){wh, wh};
                    const unsigned vw[8] = {v0.x, v0.y, v0.z, v0.w, v1.x, v1.y, v1.z, v1.w};
#pragma unroll
                    for (int c8 = 0; c8 < 8; ++c8) {
                        acc[c8][0] = __builtin_elementwise_fma(w2, __builtin_bit_cast(h16x2, __builtin_amdgcn_cvt_scalef32_pk_f16_fp4(vw[c8], 1.0f, 0)), acc[c8][0]); acc[c8][1] = __builtin_elementwise_fma(w2, __builtin_bit_cast(h16x2, __builtin_amdgcn_cvt_scalef32_pk_f16_fp4(vw[c8], 1.0f, 1)), acc[c8][1]);
                        acc[c8][2] = __builtin_elementwise_fma(w2, __builtin_bit_cast(h16x2, __builtin_amdgcn_cvt_scalef32_pk_f16_fp4(vw[c8], 1.0f, 2)), acc[c8][2]); acc[c8][3] = __builtin_elementwise_fma(w2, __builtin_bit_cast(h16x2, __builtin_amdgcn_cvt_scalef32_pk_f16_fp4(vw[c8], 1.0f, 3)), acc[c8][3]); }
                }
            }
        }
        { float ss = 0.f;
          const u32x4* ib = (const u32x4*)(x1b + (size_t)tok * 1024 + 64 * j); u32x4* ob = (u32x4*)(x2b + (size_t)tok * 1024 + 64 * j);
#pragma unroll
          for (int c8 = 0; c8 < 8; ++c8) { const u32x4 r = ib[c8];
              float xv[8];
              xv[0] = bf_lo(r.x); xv[1] = bf_hi(r.x); xv[2] = bf_lo(r.y); xv[3] = bf_hi(r.y); xv[4] = bf_lo(r.z); xv[5] = bf_hi(r.z); xv[6] = bf_lo(r.w); xv[7] = bf_hi(r.w);
#pragma unroll
              for (int c = 0; c < 4; ++c) { xv[2 * c] += (float)acc[c8][c].x * 0.0625f; xv[2 * c + 1] += (float)acc[c8][c].y * 0.0625f; ss += xv[2 * c] * xv[2 * c] + xv[2 * c + 1] * xv[2 * c + 1]; }
              ob[c8] = (u32x4){cvt_pk_bf16(xv[0], xv[1]), cvt_pk_bf16(xv[2], xv[3]), cvt_pk_bf16(xv[4], xv[5]), cvt_pk_bf16(xv[6], xv[7])}; }
          ss = dpp_row_sum(ss);
          if (j == 0) rowf[2 * TG + tok] = rsqrtf(ss * (1.f / 1024.f) + EPS); }
        asm volatile("s_waitcnt lgkmcnt(0)" ::: "memory");
    }
}

__device__ __forceinline__ void phase_final(const Params& P, int g) {
    const int lane = TIDX() & 63, gw = BIDX() * 8 + (TIDX() >> 6), NGW = gridDim.x * 8;
    float* xo = P.out + (size_t)g * TG * 1024; const bf16_t* x3b = (const bf16_t*)(P.ws + A_X3B); const float* rowf = (const float*)(P.ws + WS_ROW); const float* gf = P.in[IN_FG];
    f32x4 gv[2][2];
#pragma unroll
    for (int j = 0; j < 2; ++j) { gv[j][0] = ((const f32x4*)gf)[2 * (lane + 64 * j)]; gv[j][1] = ((const f32x4*)gf)[2 * (lane + 64 * j) + 1]; }
    for (int row0 = gw * 8; row0 < TG; row0 += NGW * 8) {
        u32x4 v[8][2]; float sq[8];
#pragma unroll
        for (int rr = 0; rr < 8; ++rr) { const u32x4* xr = (const u32x4*)(x3b + (size_t)(row0 + rr) * 1024) + lane; sq[rr] = (float)__float_as_uint(rowf[(3 + g) * TG + row0 + rr]) * RSQ_INV;
#pragma unroll
            for (int j = 0; j < 2; ++j) v[rr][j] = xr[64 * j]; }
#pragma unroll
        for (int rr = 0; rr < 8; ++rr) { const float sc = rsqrtf(sq[rr] * (1.f / 1024.f) + EPS); f32x4* xr = (f32x4*)(xo + (size_t)(row0 + rr) * 1024) + 2 * lane;
#pragma unroll
            for (int j = 0; j < 2; ++j) { const u32x4 w = v[rr][j];
                xr[128 * j] = (f32x4){bf_lo(w.x), bf_hi(w.x), bf_lo(w.y), bf_hi(w.y)} * sc * gv[j][0]; xr[128 * j + 1] = (f32x4){bf_lo(w.z), bf_hi(w.z), bf_lo(w.w), bf_hi(w.w)} * sc * gv[j][1]; } }
    }
}

#define XB_TMO      128
#define XB_XCNT(j)  (256  + 64 * (j))
#define XB_XSUB(j)  (1280 + 64 * (j))
#define XB_XGEN(j)  (2304 + 64 * (j))
#define XB_TOP      3328
#define XB_TOPGEN   3392
#define XCD_BAR_WORDS 3456
#define XB_SPIN_CAP (1u << 18)
__device__ __forceinline__ unsigned xb_ld(unsigned* p)              { return __hip_atomic_load(p, __ATOMIC_RELAXED, __HIP_MEMORY_SCOPE_AGENT); }
__device__ __forceinline__ unsigned xb_add(unsigned* p, unsigned v) { return __hip_atomic_fetch_add(p, v, __ATOMIC_RELAXED, __HIP_MEMORY_SCOPE_AGENT); }
__device__ __forceinline__ unsigned xb_xcc_id() { return (unsigned)__builtin_amdgcn_s_getreg((3 << 11) | 20) & 0xFu; }
#define XB_SPIN(cond, bar) do { unsigned _sp = 0; while (cond) { __builtin_amdgcn_s_sleep(1); \
    if ((++_sp & 255u) == 0u) { if (xb_ld(&(bar)[XB_TMO])) break; if (_sp > XB_SPIN_CAP) { atomicAdd(&(bar)[XB_TMO], 1u); break; } } } } while (0)
struct XcdBarrier { unsigned* bar; unsigned x; volatile LAS unsigned* st; };
__device__ __forceinline__ XcdBarrier xcd_barrier_post(unsigned* bar, volatile LAS unsigned* st) {
    XcdBarrier b; b.bar = bar; b.x = xb_xcc_id(); b.st = st;
    if (threadIdx.x == 0) (void)xb_add(&bar[XB_XCNT(b.x)], 1u);
    return b;
}
__device__ __forceinline__ void xcd_barrier_complete(unsigned* bar, unsigned x, unsigned& nloc, unsigned& nx) {
    const unsigned G = gridDim.x * gridDim.y * gridDim.z;
    unsigned sum, cnt, mine, sp = 0u;
    for (;;) {
        sum = 0u; cnt = 0u; mine = 0u;
#pragma unroll
        for (unsigned j = 0; j < 16; ++j) { const unsigned c = xb_ld(&bar[XB_XCNT(j)]); sum += c; cnt += (c > 0u) ? 1u : 0u; mine = (j == x) ? c : mine; }
        if (sum == G) break;
        __builtin_amdgcn_s_sleep(1);
        if ((++sp & 255u) == 0u) { if (xb_ld(&bar[XB_TMO])) break; if (sp > XB_SPIN_CAP) { atomicAdd(&bar[XB_TMO], 1u); break; } }
    }
    nloc = mine > 0u ? mine : 1u; nx = cnt > 0u ? cnt : 1u;
}
__device__ __forceinline__ void xcd_barrier(const XcdBarrier& b) {
    asm volatile("s_waitcnt vmcnt(0)" ::: "memory");
    __syncthreads();
    if (threadIdx.x == 0) {
        unsigned* bar = b.bar;
        __builtin_amdgcn_s_waitcnt(0);
        unsigned nloc = b.st[0], nx = b.st[1];
        if (nloc == 0u) { xcd_barrier_complete(bar, b.x, nloc, nx); b.st[0] = nloc; b.st[1] = nx; }
        const unsigned old = xb_add(&bar[XB_XSUB(b.x)], 1u);
        const unsigned gen = old / nloc;
        if (old + 1u == (gen + 1u) * nloc) {
            __builtin_amdgcn_fence(__ATOMIC_RELEASE, "agent");
            asm volatile("s_waitcnt vmcnt(0)" ::: "memory");
            const unsigned og = xb_add(&bar[XB_TOP], 1u);
            const unsigned tg = og / nx;
            if (og + 1u == (tg + 1u) * nx) xb_add(&bar[XB_TOPGEN], 1u);
            else XB_SPIN(xb_ld(&bar[XB_TOPGEN]) == tg, bar);
            __builtin_amdgcn_fence(__ATOMIC_ACQUIRE, "agent");
            xb_add(&bar[XB_XGEN(b.x)], 1u);
            asm volatile("s_waitcnt vmcnt(0)" ::: "memory");
        } else {
            XB_SPIN(xb_ld(&bar[XB_XGEN(b.x)]) == gen, bar);
            __builtin_amdgcn_fence(__ATOMIC_ACQUIRE, "agent");
            asm volatile("s_waitcnt vmcnt(0)" ::: "memory");
        }
    }
    __syncthreads();
}

__global__ void __launch_bounds__(512, 2) mk_fwd(Params P) {
    extern __shared__ __attribute__((aligned(16))) unsigned char smem[];
    LAS unsigned char* lds = (LAS unsigned char*)smem;
    cg::grid_group grid = cg::this_grid();
    const int lo = P.ph_lo, hi = P.ph_hi;
    asm volatile("s_nop 0\n\ts_nop 0\n\ts_nop 0\n\ts_nop 0");
    if (threadIdx.x < 64) ((LAS unsigned*)(lds + LDSCTL_OFF))[threadIdx.x] = 0u;
    __syncthreads();
    XcdBarrier xbar = xcd_barrier_post((unsigned*)(P.ws + WS_CTL), (volatile LAS unsigned*)(lds + LDSCTL_OFF));
#define PH_IN(k) (lo <= (k) && (k) < hi)
#define PH_END(k) do { if ((k) + 1 < hi) { if (hi > NPH) grid.sync(); else xcd_barrier(xbar); } } while (0)
#define PHASE(kk, idx, ...) if (PH_IN(idx)) { PLACE_PAD(PhasePad<kk>::N); __VA_ARGS__; PLACE_PAD((16 - PhasePad<kk>::N) % 16); PH_END(idx); }
    PHASE(11, 0, { phase_prep(P, lds); phase_conv(P, 0); })
    for (int g = 0; g < 2; ++g) {
        const int pb = 10 * g;
        unsigned char* ws = P.ws;
        float* rowf = (float*)(ws + WS_ROW); float* xo = P.out + (size_t)g * TG * 1024;
        const int G = gridDim.x;
        PHASE(1, pb + 1, { pg8::Gemm gm{(const bf16_t*)(ws + A_XBK), (const bf16_t*)(ws + WS_WIN), 1024}; pg8::StaticOrder S; S.init(TG, NIN, G, BIDX());
            EpiInProj E{rowf, P.in[IN_AB], ws, (bf16_t*)xo}; pg8::gemm_phase(lds, gm, S, E); })
        PHASE(2, pb + 2, phase_mix(P, g, lds))
        PHASE(3, pb + 3, phase_ogfix(P, g))
        PHASE(4, pb + 4, { pg8::Gemm gm{(const bf16_t*)(ws + A_OA), (const bf16_t*)(ws + WS_WUP), 512}; pg8::PairOrder S; S.init(TG, 1024, G, BIDX());
            EpiUp E{(const unsigned char*)xo, (bf16_t*)(ws + A_MERGED)}; pg8::gemm_phase(lds, gm, S, E); })
        PHASE(5, pb + 5, { pg8::Gemm gm{(const bf16_t*)(ws + A_MERGED), (const bf16_t*)(ws + WS_WOUT), 1024}; pg8::StaticOrder S; S.init(TG, 1024, G, BIDX());
            EpiOut E{(const bf16_t*)(ws + A_XBK), (bf16_t*)(ws + A_X1B), (unsigned*)(rowf + TG)}; pg8::gemm_phase(lds, gm, S, E); })
        PHASE(6, pb + 6, {
            { pg8::Gemm gm{(const bf16_t*)(ws + A_PB), (const bf16_t*)(ws + WS_WPLE), 256}; pg8::StaticOrder S; S.init(TG, 1024, G, BIDX());
              EpiPe E{(bf16_t*)(ws + A_PE)}; pg8::gemm_phase(lds, gm, S, E); }
            { pg8::Gemm gm{(const bf16_t*)(ws + A_X1B), (const bf16_t*)(ws + WS_WQ), 1024}; pg8::StaticOrder S; S.init(TG, 2048, G, BIDX());
              EpiQ E{(const unsigned*)(rowf + TG), (bf16_t*)(ws + A_Q)}; pg8::gemm_phase(lds, gm, S, E); } })
        PHASE(7, pb + 7, phase_topk(P, g, lds))
        PHASE(8, pb + 8, phase_gather(P, g, lds))
        PHASE(9, pb + 9, { pg8::Gemm gm{(const bf16_t*)(ws + A_X2B), (const bf16_t*)(ws + WS_WGATE), 1024}; pg8::StaticOrder S; S.init(TG, 1024, G, BIDX());
            EpiGate E{rowf + 2 * TG, (const bf16_t*)(ws + A_PE), (const bf16_t*)(ws + A_X2B), (bf16_t*)(ws + A_X3B), (unsigned*)(rowf + (3 + g) * TG)}; pg8::gemm_phase(lds, gm, S, E); })
        PHASE(10, pb + 10, { phase_final(P, g); if (g == 0) phase_conv(P, 1); })
    }
#undef PHASE
#undef PH_IN
#undef PH_END
}

extern "C" void kernel_launch(void* const* d_in, const int* in_sizes, int n_in, void* d_out, int out_size, void* d_ws, size_t ws_size, hipStream_t stream) {
    static int grid = 0;
    if (grid == 0) {
        if (n_in != 24 || ws_size < WS_END) { fprintf(stderr, "kernel_launch: need 24 inputs and >= %zu bytes of workspace (got %d, %zu)\n", (size_t)WS_END, n_in, ws_size); grid = -1; return; }
        if (hipFuncSetAttribute((const void*)mk_fwd, hipFuncAttributeMaxDynamicSharedMemorySize, LDS_BYTES) != hipSuccess) { fprintf(stderr, "kernel_launch: hipFuncSetAttribute failed\n"); grid = -1; return; }
        int dev = 0, cus = 0, per_cu = 0; (void)hipGetDevice(&dev); (void)hipDeviceGetAttribute(&cus, hipDeviceAttributeMultiprocessorCount, dev);
        if (hipOccupancyMaxActiveBlocksPerMultiprocessor(&per_cu, (const void*)mk_fwd, 512, LDS_BYTES) != hipSuccess || per_cu < 1) per_cu = 1;
        (void)hipGetLastError();
        grid = (cus > 0 ? cus : 256) * (per_cu > 1 ? 1 : per_cu);
    }
    if (grid < 0) return;
    Params P{};
    for (int i = 0; i < 24; ++i) P.in[i] = (const float*)d_in[i];
    P.out = (float*)d_out; P.ws = (unsigned char*)d_ws;
    P.ph_lo = 0; P.ph_hi = NPH;
    (void)hipMemsetAsync((unsigned char*)d_ws + WS_CTL, 0, 32768, stream);
    { void* args[] = {&P};
      hipError_t e = hipLaunchCooperativeKernel((const void*)mk_fwd, dim3(grid), dim3(512), args, LDS_BYTES, stream);
      if (e != hipSuccess) fprintf(stderr, "cooperative launch failed: %s (grid %d)\n", hipGetErrorString(e), grid); }
}
```
